# Optimizing an MI355X kernel written in HIP

```python
import math
import jax
import jax.numpy as jnp
from jax import lax
import numpy as np

D_MODEL = 4096
BATCH = 1
SEQ = 16384
DEPTH = 4

HEAD_DIM = 128
N_HEADS = D_MODEL // HEAD_DIM
N_HEADS_A = N_HEADS // 2
N_HEADS_B = N_HEADS - N_HEADS_A
D_A = N_HEADS_A * HEAD_DIM
D_B = N_HEADS_B * HEAD_DIM
D_MIX = D_A + D_B
DILATED_PATTERNS = ((128, 1), (512, 4), (2048, 16))
Q_BLOCK = 128
NSA_KV_HEADS = 2
NSA_GROUP = N_HEADS_B // NSA_KV_HEADS
D_KV_B = NSA_KV_HEADS * HEAD_DIM
CMP_BLOCK = 32
CMP_STRIDE = 16
CMP_HIDDEN = 2 * HEAD_DIM
SLC_BLOCK = 64
SLC_TOP = 16
SLC_LOCAL = 2
WIN_B = 512
NORM_EPS = 1e-6

kernel_name = 'hybrid_dilated_nsa_block'


def _in_widths():
    return (D_A, D_A, D_A, D_A, D_B, D_KV_B, D_KV_B, D_KV_B, D_KV_B, D_KV_B, D_KV_B, D_B,
            3 * N_HEADS_B)


def _split_points():
    w = _in_widths()
    return [sum(w[:i + 1]) for i in range(len(w) - 1)]


def _alibi_slopes(n):
    return jnp.exp2(-8.0 * jnp.arange(1, n + 1, dtype=jnp.float32) / n)


def _rmsnorm(x, g):
    xf = x.astype(jnp.float32)
    y = xf * lax.rsqrt(jnp.mean(xf * xf, axis=-1, keepdims=True) + NORM_EPS)
    return (y * g.astype(jnp.float32)).astype(x.dtype)


def _masked_softmax(scores, valid):
    s = jnp.where(valid, scores, -jnp.inf)
    m = jnp.max(s, axis=-1, keepdims=True)
    m = jnp.where(jnp.isfinite(m), m, 0.0)
    e = jnp.exp(s - m)
    den = jnp.sum(e, axis=-1, keepdims=True)
    den = jnp.where(den > 0, den, 1.0)
    return e / den, (m + jnp.log(den))[..., 0]


def _dilated_branch(q, k, v, window, dilation, slopes):
    B, S, H, hd = q.shape
    L = S // dilation
    W = window // dilation
    nb = -(-L // W)
    Lp = nb * W

    def sub(t, front):
        t = t.reshape(B, L, dilation, H, hd).transpose(0, 2, 1, 3, 4)
        return jnp.pad(t, ((0, 0), (0, 0), (front, Lp - L), (0, 0), (0, 0)))

    qb = sub(q, 0).reshape(B, dilation, nb, W, H, hd)

    def band(t):
        tp = sub(t, W).reshape(B, dilation, nb + 1, W, H, hd)
        return jnp.concatenate([tp[:, :, :-1], tp[:, :, 1:]], axis=3)

    kb, vb = band(k), band(v)
    scores = jnp.einsum('brnqhd,brnkhd->brnhqk', qb, kb)
    dist = W + jnp.arange(W)[:, None] - jnp.arange(2 * W)[None, :]
    key_idx = (jnp.arange(nb)[:, None] - 1) * W + jnp.arange(2 * W)[None, :]
    valid = ((dist >= 0) & (dist <= W))[None] & (key_idx >= 0)[:, None, :]
    scores = scores - slopes[:, None, None] * (dilation * dist).astype(jnp.float32)
    p, lse = _masked_softmax(scores, valid[None, None, :, None])
    o = jnp.einsum('brnhqk,brnkhd->brnqhd', p, vb)
    o = o.reshape(B, dilation, Lp, H, hd)[:, :, :L].transpose(0, 2, 1, 3, 4).reshape(B, S, H, hd)
    lse = lse.transpose(0, 1, 2, 4, 3).reshape(B, dilation, Lp, H)[:, :, :L]
    lse = lse.transpose(0, 2, 1, 3).reshape(B, S, H)
    return o, lse


def _dilated_mixture(q, k, v, slopes):
    outs, lses = [], []
    for window, dilation in DILATED_PATTERNS:
        o, l = _dilated_branch(q, k, v, window, dilation, slopes)
        outs.append(o)
        lses.append(l)
    w = jax.nn.softmax(jnp.stack(lses, axis=0), axis=0)
    return jnp.einsum('ibsh,ibshd->bshd', w, jnp.stack(outs, axis=0))


def _compress(t, pe, w1, w2):
    B, S, G, hd = t.shape
    n_c = (S - CMP_BLOCK) // CMP_STRIDE + 1
    idx = jnp.arange(n_c)[:, None] * CMP_STRIDE + jnp.arange(CMP_BLOCK)[None, :]
    blocks = t[:, idx] + pe.astype(jnp.float32)[None, None, :, None, :]
    flat = blocks.transpose(0, 1, 3, 2, 4).reshape(B, n_c, G, CMP_BLOCK * hd)
    return jax.nn.gelu(flat @ w1) @ w2


def _nsa(q, kc, vc, ks, vs, kw, vw, gates, slopes, k_pe, k_w1, k_w2, v_pe, v_w1, v_w2):
    B, S, H, hd = q.shape
    G, R = NSA_KV_HEADS, NSA_GROUP
    kcmp = _compress(kc, k_pe, k_w1, k_w2)
    vcmp = _compress(vc, v_pe, v_w1, v_w2)
    n_c = kcmp.shape[1]
    c_start = jnp.arange(n_c) * CMP_STRIDE
    c_end = c_start + CMP_BLOCK - 1
    n_s = S // SLC_BLOCK
    top = min(SLC_TOP, n_s)
    blk = jnp.arange(n_s)
    j_start = blk * SLC_BLOCK
    overlap = ((c_start[:, None] < j_start[None, :] + SLC_BLOCK)
               & (c_end[:, None] >= j_start[None, :])).astype(jnp.float32)
    ks_b = ks.reshape(B, n_s, SLC_BLOCK, G, hd).transpose(0, 3, 1, 2, 4)
    vs_b = vs.reshape(B, n_s, SLC_BLOCK, G, hd).transpose(0, 3, 1, 2, 4)
    kw_p = jnp.pad(kw, ((0, 0), (WIN_B, 0), (0, 0), (0, 0)))
    vw_p = jnp.pad(vw, ((0, 0), (WIN_B, 0), (0, 0), (0, 0)))
    qg = q.reshape(B, S, G, R, hd) * (hd ** -0.5)
    gg = gates.reshape(B, S, G, R, 3)
    sl = slopes.reshape(G, R)
    b_ix = jnp.arange(B)[:, None, None, None]
    g_ix = jnp.arange(G)[None, :, None, None]

    def one_block(n):
        t0 = n * Q_BLOCK
        t = t0 + jnp.arange(Q_BLOCK)
        qb = lax.dynamic_slice_in_dim(qg, t0, Q_BLOCK, axis=1)
        dist_c = t[:, None] - c_end[None, :]
        sc = (jnp.einsum('bqgrd,bcgd->bgrqc', qb, kcmp)
              - sl[:, :, None, None] * dist_c.astype(jnp.float32))
        p_c, _ = _masked_softmax(sc, dist_c >= 0)
        o_c = jnp.einsum('bgrqc,bcgd->bqgrd', p_c, vcmp)
        imp = jnp.einsum('bgrqc,cj->bgqj', p_c, overlap)
        cur = (t // SLC_BLOCK)[:, None]
        causal_blk = blk[None, :] <= cur
        forced = (blk[None, :] == 0) | (causal_blk & ((cur - blk[None, :]) < SLC_LOCAL))
        imp = jnp.where(forced, jnp.inf, jnp.where(causal_blk, imp, -jnp.inf))
        vals, idx = lax.top_k(imp, top)
        k_sel = ks_b[b_ix, g_ix, idx]
        v_sel = vs_b[b_ix, g_ix, idx]
        pos_s = idx[..., None] * SLC_BLOCK + jnp.arange(SLC_BLOCK)
        dist_s = (t[:, None, None] - pos_s)[:, :, None]
        valid_s = (vals > -jnp.inf)[:, :, None, :, :, None] & (dist_s >= 0)
        ss = (jnp.einsum('bqgrd,bgqjsd->bgrqjs', qb, k_sel)
              - sl[None, :, :, None, None, None] * dist_s.astype(jnp.float32))
        p_s, _ = _masked_softmax(ss.reshape(B, G, R, Q_BLOCK, top * SLC_BLOCK),
                                 valid_s.reshape(B, G, 1, Q_BLOCK, top * SLC_BLOCK))
        o_s = jnp.einsum('bgrqjs,bgqjsd->bqgrd', p_s.reshape(ss.shape), v_sel)
        kwb = lax.dynamic_slice_in_dim(kw_p, t0, Q_BLOCK + WIN_B, axis=1)
        vwb = lax.dynamic_slice_in_dim(vw_p, t0, Q_BLOCK + WIN_B, axis=1)
        pos_w = t0 - WIN_B + jnp.arange(Q_BLOCK + WIN_B)
        dist_w = t[:, None] - pos_w[None, :]
        valid_w = (dist_w >= 0) & (dist_w < WIN_B) & (pos_w[None, :] >= 0)
        sw = (jnp.einsum('bqgrd,bkgd->bgrqk', qb, kwb)
              - sl[:, :, None, None] * dist_w.astype(jnp.float32))
        p_w, _ = _masked_softmax(sw, valid_w)
        o_w = jnp.einsum('bgrqk,bkgd->bqgrd', p_w, vwb)
        gb = lax.dynamic_slice_in_dim(gg, t0, Q_BLOCK, axis=1)
        return gb[..., 0:1] * o_c + gb[..., 1:2] * o_s + gb[..., 2:3] * o_w

    out = lax.map(one_block, jnp.arange(S // Q_BLOCK))
    return out.transpose(1, 0, 2, 3, 4, 5).reshape(B, S, H * hd)


def setup_inputs(seed: int = 0) -> dict:
    key = jax.random.key(seed)
    ks = jax.random.split(key, 14)
    d_in = sum(_in_widths())
    f = CMP_BLOCK * HEAD_DIM
    nrm = jax.random.normal
    return {
        'x': nrm(ks[0], (BATCH, SEQ, D_MODEL), jnp.float32),
        'norm_g': 1.0 + 0.02 * nrm(ks[1], (DEPTH, D_MODEL), jnp.float32),
        'w_in': nrm(ks[2], (DEPTH, D_MODEL, d_in), jnp.float32) * D_MODEL ** -0.5,
        'cmp_k_pe': 0.1 * nrm(ks[3], (DEPTH, CMP_BLOCK, HEAD_DIM), jnp.float32),
        'cmp_k_w1': nrm(ks[4], (DEPTH, f, CMP_HIDDEN), jnp.float32) * f ** -0.5,
        'cmp_k_w2': nrm(ks[5], (DEPTH, CMP_HIDDEN, HEAD_DIM), jnp.float32) * CMP_HIDDEN ** -0.5,
        'cmp_v_pe': 0.1 * nrm(ks[6], (DEPTH, CMP_BLOCK, HEAD_DIM), jnp.float32),
        'cmp_v_w1': nrm(ks[7], (DEPTH, f, CMP_HIDDEN), jnp.float32) * f ** -0.5,
        'cmp_v_w2': nrm(ks[8], (DEPTH, CMP_HIDDEN, HEAD_DIM), jnp.float32) * CMP_HIDDEN ** -0.5,
        'out_g_a': 1.0 + 0.02 * nrm(ks[9], (DEPTH, D_A), jnp.float32),
        'out_g_b': 1.0 + 0.02 * nrm(ks[10], (DEPTH, D_B), jnp.float32),
        'w_out': nrm(ks[11], (DEPTH, D_MIX, D_MODEL), jnp.float32) * D_MIX ** -0.5,
        'final_g': 1.0 + 0.02 * nrm(ks[12], (D_MODEL,), jnp.float32),
    }


def reference(x, norm_g, w_in, cmp_k_pe, cmp_k_w1, cmp_k_w2, cmp_v_pe, cmp_v_w1, cmp_v_w2,
              out_g_a, out_g_b, w_out, final_g):
    B, S, _ = x.shape
    slopes_a = _alibi_slopes(N_HEADS_A)
    slopes_b = _alibi_slopes(N_HEADS_B)

    def heads(t, n):
        return t.astype(jnp.float32).reshape(B, S, n, HEAD_DIM)

    for l in range(DEPTH):
        h = _rmsnorm(x, norm_g[l])
        proj = h @ w_in[l]
        (q_a, k_a, v_a, z_a, q_b, kc, vc, ksl, vsl, kwn, vwn, z_b, g_b) = jnp.split(
            proj, _split_points(), axis=-1)
        o_a = _dilated_mixture(heads(q_a, N_HEADS_A) * (HEAD_DIM ** -0.5), heads(k_a, N_HEADS_A),
                               heads(v_a, N_HEADS_A), slopes_a).reshape(B, S, D_A)
        gates = jax.nn.sigmoid(g_b.astype(jnp.float32)).reshape(B, S, N_HEADS_B, 3)
        o_b = _nsa(heads(q_b, N_HEADS_B), heads(kc, NSA_KV_HEADS), heads(vc, NSA_KV_HEADS),
                   heads(ksl, NSA_KV_HEADS), heads(vsl, NSA_KV_HEADS),
                   heads(kwn, NSA_KV_HEADS), heads(vwn, NSA_KV_HEADS), gates, slopes_b,
                   cmp_k_pe[l], cmp_k_w1[l], cmp_k_w2[l], cmp_v_pe[l], cmp_v_w1[l], cmp_v_w2[l])
        y_a = _rmsnorm(o_a, out_g_a[l]) * jax.nn.silu(z_a.astype(jnp.float32))
        y_b = _rmsnorm(o_b, out_g_b[l]) * jax.nn.silu(z_b.astype(jnp.float32))
        y = jnp.concatenate([y_a, y_b], axis=-1).astype(x.dtype) @ w_out[l]
        x = x + y.astype(x.dtype)
    return _rmsnorm(x, final_g)
```

```cpp
#include <hip/hip_runtime.h>
#include <cstdio>
#include <cstdint>

#ifndef MK_FUSED
#define MK_FUSED 1
#endif

#define LAS __attribute__((address_space(3)))
#define GAS __attribute__((address_space(1)))
#define DEV __device__ __forceinline__
typedef _Float16 f16;
typedef _Float16 f16x2 __attribute__((ext_vector_type(2)));
typedef _Float16 f16x4 __attribute__((ext_vector_type(4)));
typedef _Float16 f16x8 __attribute__((ext_vector_type(8)));
typedef short s16x4 __attribute__((ext_vector_type(4)));
typedef float f32x2 __attribute__((ext_vector_type(2)));
typedef float f32x4 __attribute__((ext_vector_type(4)));
typedef float f32x16 __attribute__((ext_vector_type(16)));
typedef unsigned u32x2 __attribute__((ext_vector_type(2)));
typedef unsigned u32x4 __attribute__((ext_vector_type(4)));

constexpr int S = 16384, D = 4096, DEPTH = 4, HD = 128;
constexpr int NIN = 13872, NINP = 14080;
constexpr int C_QA = 0, C_KA = 2048, C_VA = 4096, C_ZA = 6144, C_QB = 8192, C_KC = 10240, C_VC = 10496, C_KS = 10752, C_VS = 11008, C_KW = 11264, C_VW = 11520, C_ZB = 11776, C_GT = 13824;
constexpr int DA = 2048, DB = 2048;
constexpr float EPS = 1e-6f;
constexpr float LOG2E = 1.4426950408889634f;
constexpr float QSCALE2 = 0.08838834764831845f * 1.4426950408889634f;
constexpr int NWAVES = 8, NTHR = 512;

constexpr size_t MiB = 1u << 20;
constexpr size_t WS_CTL = 0, CTL_ZERO_BYTES = 1 * MiB;
constexpr size_t WS_WIN = 16 * MiB;
constexpr size_t WS_WOUT = 456 * MiB;
constexpr size_t WS_W1 = 584 * MiB;
constexpr size_t WS_W2 = 600 * MiB;
constexpr size_t WS_CMP = 602 * MiB;
constexpr size_t WS_LSE = 604 * MiB;
constexpr size_t WS_H = 608 * MiB;
constexpr size_t WS_PROJ = 736 * MiB;
constexpr size_t WS_OA = 1176 * MiB;
constexpr size_t WS_OB = 1368 * MiB;
constexpr size_t WS_Y = 1560 * MiB;
constexpr size_t WS_RS = 603 * MiB;
constexpr size_t WS_RSP = 1688 * MiB;
constexpr size_t WS_END = 1692 * MiB;
constexpr int CW_BAR = 4096;
constexpr int CW_CMPD = 32768;
constexpr int CW_GRP = 49152;
constexpr int CW_KMX = 16384;
constexpr float SKIP_LOG2 = -160.0f;

constexpr int RING_BYTES = 155648;
constexpr int MISC_OFF = RING_BYTES;
constexpr int LDS_BYTES = RING_BYTES + 1024;

#define LDS_WAIT() asm volatile("s_waitcnt lgkmcnt(0)" ::: "memory")
#define VM_WAIT() asm volatile("s_waitcnt vmcnt(0)" ::: "memory")

DEV unsigned pk2h(float lo, float hi) { f16x2 v = {(f16)lo, (f16)hi}; return __builtin_bit_cast(unsigned, v); }
DEV float wave_sum(float v) {
#pragma unroll
    for (int o = 1; o < 64; o <<= 1) v += __shfl_xor(v, o);
    return v;
}
DEV float fexp2(float x) { return __builtin_amdgcn_exp2f(x); }

#define XB_TMO      128
#define XB_XCNT(j)  (256  + 64 * (j))
#define XB_XSUB(j)  (1280 + 64 * (j))
#define XB_XGEN(j)  (2304 + 64 * (j))
#define XB_TOP      3328
#define XB_TOPGEN   3392
#define XCD_BAR_WORDS 3456
#define XB_SPIN_CAP (1u << 18)
__device__ __forceinline__ unsigned xb_ld(unsigned* p)              { return __hip_atomic_load(p, __ATOMIC_RELAXED, __HIP_MEMORY_SCOPE_AGENT); }
__device__ __forceinline__ unsigned xb_add(unsigned* p, unsigned v) { return __hip_atomic_fetch_add(p, v, __ATOMIC_RELAXED, __HIP_MEMORY_SCOPE_AGENT); }
__device__ __forceinline__ unsigned xb_xcc_id() { return (unsigned)__builtin_amdgcn_s_getreg((3 << 11) | 20) & 0xFu; }
#define XB_SPIN(cond, bar) do { unsigned _sp = 0; while (cond) { __builtin_amdgcn_s_sleep(1); \
    if ((++_sp & 255u) == 0u) { if (xb_ld(&(bar)[XB_TMO])) break; if (_sp > XB_SPIN_CAP) { atomicAdd(&(bar)[XB_TMO], 1u); break; } } } } while (0)
struct XcdBarrier { unsigned* bar; unsigned x; volatile LAS unsigned* st; };
__device__ __forceinline__ XcdBarrier xcd_barrier_post(unsigned* bar, volatile LAS unsigned* st) {
    XcdBarrier b; b.bar = bar; b.x = xb_xcc_id(); b.st = st;
    if (threadIdx.x == 0) (void)xb_add(&bar[XB_XCNT(b.x)], 1u);
    return b;
}
__device__ __forceinline__ void xcd_barrier_complete(unsigned* bar, unsigned x, unsigned& nloc, unsigned& nx) {
    const unsigned G = gridDim.x * gridDim.y * gridDim.z;
    unsigned sum, cnt, mine, sp = 0u;
    for (;;) {
        sum = 0u; cnt = 0u; mine = 0u;
#pragma unroll
        for (unsigned j = 0; j < 16; ++j) { const unsigned c = xb_ld(&bar[XB_XCNT(j)]); sum += c; cnt += (c > 0u) ? 1u : 0u; mine = (j == x) ? c : mine; }
        if (sum == G) break;
        __builtin_amdgcn_s_sleep(1);
        if ((++sp & 255u) == 0u) { if (xb_ld(&bar[XB_TMO])) break; if (sp > XB_SPIN_CAP) { atomicAdd(&bar[XB_TMO], 1u); break; } }
    }
    nloc = mine > 0u ? mine : 1u; nx = cnt > 0u ? cnt : 1u;
}
__device__ __forceinline__ void xcd_barrier(const XcdBarrier& b) {
    asm volatile("s_waitcnt vmcnt(0)" ::: "memory");
    __syncthreads();
    if (threadIdx.x == 0) {
        unsigned* bar = b.bar;
        __builtin_amdgcn_s_waitcnt(0);
        unsigned nloc = b.st[0], nx = b.st[1];
        if (nloc == 0u) { xcd_barrier_complete(bar, b.x, nloc, nx); b.st[0] = nloc; b.st[1] = nx; }
        const unsigned old = xb_add(&bar[XB_XSUB(b.x)], 1u);
        const unsigned gen = old / nloc;
        if (old + 1u == (gen + 1u) * nloc) {
            __builtin_amdgcn_fence(__ATOMIC_RELEASE, "agent");
            asm volatile("s_waitcnt vmcnt(0)" ::: "memory");
            const unsigned og = xb_add(&bar[XB_TOP], 1u);
            const unsigned tg = og / nx;
            if (og + 1u == (tg + 1u) * nx) xb_add(&bar[XB_TOPGEN], 1u);
            else XB_SPIN(xb_ld(&bar[XB_TOPGEN]) == tg, bar);
            __builtin_amdgcn_fence(__ATOMIC_ACQUIRE, "agent");
            xb_add(&bar[XB_XGEN(b.x)], 1u);
            asm volatile("s_waitcnt vmcnt(0)" ::: "memory");
        } else {
            XB_SPIN(xb_ld(&bar[XB_XGEN(b.x)]) == gen, bar);
            __builtin_amdgcn_fence(__ATOMIC_ACQUIRE, "agent");
            asm volatile("s_waitcnt vmcnt(0)" ::: "memory");
        }
    }
    __syncthreads();
}

__device__ __forceinline__ void group_barrier(unsigned* cnt, unsigned gsz, unsigned* bar) {
    asm volatile("s_waitcnt vmcnt(0)" ::: "memory");
    __syncthreads();
    if (threadIdx.x == 0) {
        __builtin_amdgcn_fence(__ATOMIC_RELEASE, "agent");
        asm volatile("s_waitcnt vmcnt(0)" ::: "memory");
        const unsigned old = xb_add(cnt, 1u);
        const unsigned target = (old / gsz + 1u) * gsz;
        XB_SPIN(xb_ld(cnt) < target, bar);
        __builtin_amdgcn_fence(__ATOMIC_ACQUIRE, "agent");
        asm volatile("s_waitcnt vmcnt(0)" ::: "memory");
    }
    __syncthreads();
}

namespace pg8 {
constexpr int BM = 256, BK = 64, HALF = 128, HTB = HALF * BK * 2, STAGE_BYTES = 8 * HTB, NXCD = 8, WGM = 8;
__host__ __device__ __forceinline__ int lds_byte(int r, int c) { const int st = (r >> 4) * 2 + (c >> 5), rr = r & 15, cc = c & 31, ob = rr * 64 + cc * 2; return st * 1024 + (ob ^ (((ob >> 9) & 1) << 5)); }
__host__ __device__ __forceinline__ void stage_rc(int b, int& R, int& C) { const int st = b / 1024, sb = b % 1024, swz = sb ^ (((sb >> 9) & 1) << 5); R = (st >> 1) * 16 + swz / 64; C = (st & 1) * 32 + (swz % 64) / 2; }
__host__ __device__ __forceinline__ int perm32(int rho) { const int n = rho >> 4, i = rho & 15; return 8 * (i >> 2) + 4 * n + (i & 3); }
struct Unit { int pm, pn; };
struct Gemm { const f16* A; const f16* Bt; int M, N, K; };
struct StaticOrder {
    int nM, nN, nwg, G, c;
    __device__ void init(int M, int N, int G_, int c_) { nM = M / BM; nN = N / BM; nwg = nM * nN; G = G_; c = c_; }
    __device__ bool next(int i, Unit& u) const {
        const long L = (long)i * G + c; if (L >= nwg) return false;
        int wgid = (int)L; { const int q = nwg / NXCD, r = nwg % NXCD, xcd = wgid % NXCD, off = wgid / NXCD; wgid = (xcd < r ? xcd * (q + 1) : r * (q + 1) + (xcd - r) * q) + off; }
        const int nig = WGM * nN, gid = wgid / nig, fm = gid * WGM, gsz = (nM - fm) < WGM ? (nM - fm) : WGM;
        u.pm = fm + ((wgid % nig) % gsz); u.pn = (wgid % nig) / gsz; return true;
    }
    __device__ __forceinline__ void a_ready(const Unit&) const {}
    __device__ __forceinline__ void done(const Unit&) const {}
};
struct EpiF16 {
    static constexpr bool PERM = true, AFTER_DRAIN = false;
    f16* O; int ldc; const float* rs; int* kmx;
    __device__ __forceinline__ void operator()(const f32x4 (&acc)[2][2][4][2], const Unit& u, int wr, int wc, int fr, int fq) const {
        const int row0 = u.pm * BM + wr * 64 + fr; const int col0 = u.pn * BM + wc * 32 + 8 * fq;
        const int kslot = (u.pn >= 8 && u.pn < 16) ? 2 * (u.pn - 8) : (u.pn == 42 ? 16 : (u.pn == 44 ? 18 : -1));
        float rmax[2] = {0.f, 0.f};
#pragma unroll
        for (int ai = 0; ai < 2; ++ai)
#pragma unroll
            for (int m = 0; m < 4; ++m) { const int row = row0 + ai * HALF + m * 16; f16* rowp = O + (size_t)row * ldc + col0; const float sc = rs[row];
#pragma unroll
                for (int bj = 0; bj < 2; ++bj) { const f32x4 v0 = acc[ai][bj][m][0] * sc, v1 = acc[ai][bj][m][1] * sc;
                    u32x4 w; w.x = pk2h(v0[0], v0[1]); w.y = pk2h(v0[2], v0[3]); w.z = pk2h(v1[0], v1[1]); w.w = pk2h(v1[2], v1[3]);
                    *(u32x4*)(rowp + bj * HALF) = w;
                    if (kslot >= 0) { float s8 = ((v0[0] * v0[0] + v0[1] * v0[1]) + (v0[2] * v0[2] + v0[3] * v0[3])) + ((v1[0] * v1[0] + v1[1] * v1[1]) + (v1[2] * v1[2] + v1[3] * v1[3]));
                        s8 += __shfl_xor(s8, 16); s8 += __shfl_xor(s8, 32); rmax[bj] = fmaxf(rmax[bj], s8); } } }
        if (kslot >= 0) {
#pragma unroll
            for (int bj = 0; bj < 2; ++bj) { float v = rmax[bj];
#pragma unroll
                for (int o = 1; o < 16; o <<= 1) v = fmaxf(v, __shfl_xor(v, o));
                if (fr == 0 && fq == 0) atomicMax(kmx + (kslot + bj) * 4 + wc, __float_as_int(v * 1.004f)); }
        }
    }
};
struct EpiRes {
    static constexpr bool PERM = true, AFTER_DRAIN = false;
    f16* X; int ldc; float* ssp;
    __device__ __forceinline__ void operator()(const f32x4 (&acc)[2][2][4][2], const Unit& u, int wr, int wc, int fr, int fq) const {
        const int row0 = u.pm * BM + wr * 64 + fr, col0 = u.pn * BM + wc * 32 + 8 * fq;
#pragma unroll
        for (int ai = 0; ai < 2; ++ai)
#pragma unroll
            for (int m = 0; m < 4; ++m) { const int row = row0 + ai * HALF + m * 16; f16* rowp = X + (size_t)row * ldc + col0; float ss = 0.f;
#pragma unroll
                for (int bj = 0; bj < 2; ++bj) { const f16x8 xo = *(const f16x8*)(rowp + bj * HALF); f32x4 v0 = acc[ai][bj][m][0], v1 = acc[ai][bj][m][1];
                    v0[0] += (float)xo[0]; v0[1] += (float)xo[1]; v0[2] += (float)xo[2]; v0[3] += (float)xo[3]; v1[0] += (float)xo[4]; v1[1] += (float)xo[5]; v1[2] += (float)xo[6]; v1[3] += (float)xo[7];
                    ss += ((v0[0] * v0[0] + v0[1] * v0[1]) + (v0[2] * v0[2] + v0[3] * v0[3])) + ((v1[0] * v1[0] + v1[1] * v1[1]) + (v1[2] * v1[2] + v1[3] * v1[3]));
                    u32x4 w; w.x = pk2h(v0[0], v0[1]); w.y = pk2h(v0[2], v0[3]); w.z = pk2h(v1[0], v1[1]); w.w = pk2h(v1[2], v1[3]);
                    *(u32x4*)(rowp + bj * HALF) = w; }
                if (ssp) { ss += __shfl_xor(ss, 16); ss += __shfl_xor(ss, 32);
                    if (fq == 0) ssp[(size_t)row * 64 + u.pn * 4 + wc] = ss; } }
    }
};

template <class Epi, class Sched, bool ALIGN_EPI = false, bool SP2 = false>
__device__ __forceinline__ void gemm_phase(LAS unsigned char* lds, const Gemm g, const Sched& S, const Epi& E) {
    int tid = threadIdx.x; asm volatile("" : "+v"(tid));
    const int wid = __builtin_amdgcn_readfirstlane(tid >> 6), lane = tid & 63, wr = wid >> 2, wc = wid & 3, fr = lane & 15, fq = lane >> 4;
    const int K = g.K, nt = K / BK;
    unsigned voffA[2], voffB[2];
#pragma unroll
    for (int i = 0; i < 2; ++i) { int R, C; stage_rc(tid * 16 + i * 8192, R, C); const int Rb = Epi::PERM ? ((R & ~31) + perm32(R & 31)) : R;
        voffA[i] = (unsigned)(R * K + C) * 2u; voffB[i] = (unsigned)(Rb * K + C) * 2u; }
    const size_t kstep = (size_t)(BK * 2);
    const size_t hstep = (size_t)HALF * K * 2;
    const size_t tstep = 2 * hstep;
    const unsigned ldsw = (unsigned)wid * 1024u;
    const int aoff = lds_byte(wr * 64 + fr, fq * 8), boff = lds_byte(wc * 32 + fr, fq * 8);
#define PG8_SA(b, h) (((b) * 2 + (h)) * HTB)
#define PG8_SB(b, h) ((4 + (b) * 2 + (h)) * HTB)
#define PG8_STAGE(bufoff, gbase, voff) do { _Pragma("unroll") for (int _i = 0; _i < 2; ++_i) \
        __builtin_amdgcn_global_load_lds((const unsigned*)((const char*)(gbase) + (voff)[_i]), (LAS unsigned*)(lds + (bufoff) + ldsw + _i * 8192), 16, 0, 0); } while (0)
#define PG8_LDA(dst, b, h) do { _Pragma("unroll") for (int m = 0; m < 4; ++m) _Pragma("unroll") for (int k = 0; k < 2; ++k) dst[m][k] = *(const LAS f16x8*)(lds + PG8_SA(b, h) + aoff + m * 2048 + k * 1024); } while (0)
#define PG8_LDB(dst, b, h) do { _Pragma("unroll") for (int n = 0; n < 2; ++n) _Pragma("unroll") for (int k = 0; k < 2; ++k) dst[n][k] = *(const LAS f16x8*)(lds + PG8_SB(b, h) + boff + n * 2048 + k * 1024); } while (0)
#define PG8_MMA(ai, bj, At, Bt) do { __builtin_amdgcn_s_setprio(1); _Pragma("unroll") for (int m = 0; m < 4; ++m) _Pragma("unroll") for (int n = 0; n < 2; ++n) _Pragma("unroll") for (int k = 0; k < 2; ++k) \
        acc[ai][bj][m][n] = __builtin_amdgcn_mfma_f32_16x16x32_f16(Bt[n][k], At[m][k], acc[ai][bj][m][n], 0, 0, 0); __builtin_amdgcn_s_setprio(0); } while (0)
#define PG8_WAIT_V(n) asm volatile("s_waitcnt vmcnt(" #n ")" ::: "memory")
#define PG8_WAIT_L(n) asm volatile("s_waitcnt lgkmcnt(" #n ")" ::: "memory")
#define PG8_BAR __builtin_amdgcn_s_barrier()
#define PG8_SCHED __builtin_amdgcn_sched_barrier(0)
    Unit cur, nxt; int ui = 0;
    if (!S.next(0, cur)) return;
    f32x4 acc[2][2][4][2];
#pragma unroll
    for (int a = 0; a < 2; ++a)
#pragma unroll
        for (int b = 0; b < 2; ++b)
#pragma unroll
            for (int m = 0; m < 4; ++m)
#pragma unroll
                for (int n = 0; n < 2; ++n) acc[a][b][m][n] = (f32x4){0.f, 0.f, 0.f, 0.f};
    f16x8 At[4][2], B0[2][2], B1[2][2];
    const char* cA = (const char*)g.A + (size_t)cur.pm * tstep; const char* cB = (const char*)g.Bt + (size_t)cur.pn * tstep;
    S.a_ready(cur);
    if constexpr (SP2) {
        PG8_STAGE(PG8_SB(0, 0), cB, voffB); PG8_STAGE(PG8_SB(0, 1), cB + hstep, voffB); PG8_STAGE(PG8_SA(0, 0), cA, voffA); PG8_STAGE(PG8_SA(0, 1), cA + hstep, voffA);
        if (wr == 1) PG8_BAR;
        PG8_WAIT_V(2); PG8_BAR;
        PG8_STAGE(PG8_SB(1, 0), cB + kstep, voffB); PG8_STAGE(PG8_SA(1, 0), cA + kstep, voffA); PG8_STAGE(PG8_SB(1, 1), cB + hstep + kstep, voffB);
        PG8_WAIT_V(6); PG8_BAR;
    } else {
        PG8_STAGE(PG8_SB(0, 0), cB, voffB); PG8_STAGE(PG8_SA(0, 0), cA, voffA); PG8_STAGE(PG8_SB(0, 1), cB + hstep, voffB); PG8_STAGE(PG8_SA(0, 1), cA + hstep, voffA);
        if (wr == 1) PG8_BAR;
        PG8_WAIT_V(4); PG8_BAR;
        PG8_STAGE(PG8_SB(1, 0), cB + kstep, voffB); PG8_STAGE(PG8_SA(1, 0), cA + kstep, voffA); PG8_STAGE(PG8_SB(1, 1), cB + hstep + kstep, voffB);
        PG8_WAIT_V(6); PG8_BAR;
    }
    for (;;) {
        const bool has_next = S.next(ui + 1, nxt);
        const char* nA = has_next ? (const char*)g.A + (size_t)nxt.pm * tstep : cA; const char* nB = has_next ? (const char*)g.Bt + (size_t)nxt.pn * tstep : cB;
        for (int t = 0; t < nt; t += 2) {
            const bool last = (t == nt - 2);
            const char* a1 = cA + (size_t)(t + 1) * kstep;
            const char* a2 = last ? nA : cA + (size_t)(t + 2) * kstep; const char* b2 = last ? nB : cB + (size_t)(t + 2) * kstep;
            const char* a3 = a2 + kstep; const char* b3 = b2 + kstep;
            if (last && has_next) S.a_ready(nxt);
            if constexpr (SP2) {
            PG8_LDB(B0, 0, 0); PG8_LDB(B1, 0, 1); PG8_SCHED; PG8_LDA(At, 0, 0); PG8_STAGE(PG8_SA(1, 1), a1 + hstep, voffA);
            PG8_WAIT_V(8); PG8_WAIT_L(0); PG8_BAR; PG8_MMA(0, 0, At, B0); PG8_MMA(0, 1, At, B1); PG8_BAR; PG8_SCHED;
            PG8_LDA(At, 0, 1); PG8_STAGE(PG8_SB(0, 0), b2, voffB); PG8_STAGE(PG8_SB(0, 1), b2 + hstep, voffB); PG8_STAGE(PG8_SA(0, 0), a2, voffA);
            PG8_WAIT_V(8); PG8_WAIT_L(0); PG8_BAR; PG8_MMA(1, 0, At, B0); PG8_MMA(1, 1, At, B1); PG8_BAR; PG8_SCHED;
            PG8_LDB(B0, 1, 0); PG8_LDB(B1, 1, 1); PG8_SCHED; PG8_LDA(At, 1, 0); PG8_STAGE(PG8_SA(0, 1), a2 + hstep, voffA);
            PG8_WAIT_V(8); PG8_WAIT_L(0); PG8_BAR; PG8_MMA(0, 0, At, B0); PG8_MMA(0, 1, At, B1); PG8_BAR; PG8_SCHED;
            PG8_LDA(At, 1, 1); PG8_STAGE(PG8_SB(1, 0), b3, voffB); PG8_STAGE(PG8_SB(1, 1), b3 + hstep, voffB); PG8_STAGE(PG8_SA(1, 0), a3, voffA);
            PG8_WAIT_V(8); PG8_WAIT_L(0); PG8_BAR; PG8_MMA(1, 0, At, B0); PG8_MMA(1, 1, At, B1); PG8_BAR; PG8_SCHED;
            } else {
            PG8_LDB(B0, 0, 0); PG8_SCHED; PG8_LDA(At, 0, 0); PG8_STAGE(PG8_SA(1, 1), a1 + hstep, voffA);
            PG8_WAIT_L(8); PG8_BAR; PG8_WAIT_L(0); PG8_MMA(0, 0, At, B0); PG8_BAR; PG8_SCHED;
            PG8_LDB(B1, 0, 1); PG8_STAGE(PG8_SB(0, 0), b2, voffB);
            PG8_BAR; PG8_WAIT_L(0); PG8_MMA(0, 1, At, B1); PG8_BAR;
            PG8_LDA(At, 0, 1); PG8_STAGE(PG8_SA(0, 0), a2, voffA);
            PG8_BAR; PG8_WAIT_L(0); PG8_MMA(1, 0, At, B0); PG8_BAR; PG8_SCHED;
            PG8_STAGE(PG8_SB(0, 1), b2 + hstep, voffB);
            PG8_WAIT_V(6); PG8_BAR; PG8_MMA(1, 1, At, B1); PG8_BAR;
            PG8_LDB(B0, 1, 0); PG8_SCHED; PG8_LDA(At, 1, 0); PG8_STAGE(PG8_SA(0, 1), a2 + hstep, voffA);
            PG8_WAIT_L(8); PG8_BAR; PG8_WAIT_L(0); PG8_MMA(0, 0, At, B0); PG8_BAR; PG8_SCHED;
            PG8_LDB(B1, 1, 1); PG8_STAGE(PG8_SB(1, 0), b3, voffB);
            PG8_BAR; PG8_WAIT_L(0); PG8_MMA(0, 1, At, B1); PG8_BAR;
            PG8_LDA(At, 1, 1); PG8_STAGE(PG8_SA(1, 0), a3, voffA);
            PG8_BAR; PG8_WAIT_L(0); PG8_MMA(1, 0, At, B0); PG8_BAR; PG8_SCHED;
            PG8_STAGE(PG8_SB(1, 1), b3 + hstep, voffB);
            PG8_WAIT_V(6); PG8_BAR; PG8_MMA(1, 1, At, B1); PG8_BAR;
            }
        }
        if constexpr (ALIGN_EPI) { if (wr == 0) PG8_BAR; }
        if constexpr (!Epi::AFTER_DRAIN) { E(acc, cur, wr, wc, fr, fq); S.done(cur); }
        if (!has_next) break;
#pragma unroll
        for (int a = 0; a < 2; ++a)
#pragma unroll
            for (int b = 0; b < 2; ++b)
#pragma unroll
                for (int m = 0; m < 4; ++m)
#pragma unroll
                    for (int n = 0; n < 2; ++n) acc[a][b][m][n] = (f32x4){0.f, 0.f, 0.f, 0.f};
        cur = nxt; cA = nA; cB = nB; ++ui;
        if constexpr (ALIGN_EPI) { if (wr == 1) PG8_BAR; }
    }
    PG8_WAIT_V(0);
    if constexpr (!ALIGN_EPI) { if (wr == 0) PG8_BAR; }
    PG8_BAR;
#undef PG8_SA
#undef PG8_SB
#undef PG8_STAGE
#undef PG8_LDA
#undef PG8_LDB
#undef PG8_MMA
#undef PG8_WAIT_V
#undef PG8_WAIT_L
#undef PG8_BAR
#undef PG8_SCHED
}
}

struct Frame {
    LAS unsigned char* lds;
    int tid, lane, wave, vcu, G;
    const float *x, *norm_g, *w_in, *k_pe, *k_w1, *k_w2, *v_pe, *v_w1, *v_w2, *og_a, *og_b, *w_out, *fin_g;
    float* out;
    unsigned char* ws;
};

DEV void transpose_item(const float* W, int K, int N, f16* WT, LAS float* scr, int kb, int nb, int lane, const float* gk = nullptr) {
    const int k0 = 64 * kb, n0 = 32 * nb; const int nn = n0 + (lane & 31); const bool inb = nn < N;
    float tv[32];
#pragma unroll
    for (int i = 0; i < 32; ++i) { const int kk = 2 * i + (lane >> 5); tv[i] = inb ? W[(size_t)(k0 + kk) * N + nn] : 0.f; }
    if (gk) {
#pragma unroll
        for (int i = 0; i < 32; ++i) tv[i] *= gk[k0 + 2 * i + (lane >> 5)]; }
#pragma unroll
    for (int i = 0; i < 32; ++i) { const int kk = 2 * i + (lane >> 5); scr[kk * 33 + (lane & 31)] = tv[i]; }
    LDS_WAIT(); asm volatile("" ::: "memory");
    const int c = lane & 7;
#pragma unroll
    for (int j = 0; j < 4; ++j) { const int n = (lane >> 3) + 8 * j; const LAS float* s = scr + (8 * c) * 33 + n;
        u32x4 o; o.x = pk2h(s[0 * 33], s[1 * 33]); o.y = pk2h(s[2 * 33], s[3 * 33]); o.z = pk2h(s[4 * 33], s[5 * 33]); o.w = pk2h(s[6 * 33], s[7 * 33]);
        *(u32x4*)(WT + (size_t)(n0 + n) * K + k0 + 8 * c) = o; }
    LDS_WAIT(); asm volatile("" ::: "memory");
}
DEV void p0_prologue(Frame& F) {
    LAS float* scr = (LAS float*)(F.lds + F.wave * 16384);
    const int gw = F.vcu * NWAVES + F.wave, NGW = F.G * NWAVES;
    constexpr int I_IN = 64 * (NINP / 32), I_W1 = 64 * 8, I_W2 = 4 * 4;
    constexpr int PER_L = I_IN + 2 * I_W1 + 2 * I_W2;
    for (int it = gw; it < DEPTH * PER_L; it += NGW) {
        const int l = it / PER_L; int r = it % PER_L;
        if (r < I_IN) { transpose_item(F.w_in + (size_t)l * D * NIN, D, NIN, (f16*)(F.ws + WS_WIN) + (size_t)l * NINP * D, scr, r / (NINP / 32), r % (NINP / 32), F.lane, F.norm_g + (size_t)l * D); continue; } r -= I_IN;
        if (r < 2 * I_W1) { const int kv = r / I_W1; r %= I_W1; transpose_item((kv ? F.v_w1 : F.k_w1) + (size_t)l * 4096 * 256, 4096, 256, (f16*)(F.ws + WS_W1) + (size_t)(l * 2 + kv) * 256 * 4096, scr, r / 8, r % 8, F.lane); continue; } r -= 2 * I_W1;
        { const int kv = r / I_W2; r %= I_W2; transpose_item((kv ? F.v_w2 : F.k_w2) + (size_t)l * 256 * 128, 256, 128, (f16*)(F.ws + WS_W2) + (size_t)(l * 2 + kv) * 128 * 256, scr, r / 4, r % 4, F.lane); }
    }
}

DEV void backfill_wout(Frame& F, int l) {
    const int nwg = (S / 256) * (NINP / 256), nw = nwg % F.G, c = (int)blockIdx.x;
    if (nw != 0 && c < nw) return;
    const int nid = nw ? F.G - nw : F.G, me = nw ? c - nw : c;
    LAS float* scr = (LAS float*)(F.lds + F.wave * 16384);
    constexpr int I_OUT = 64 * (D / 32);
    for (int r = me * NWAVES + F.wave; r < I_OUT; r += nid * NWAVES)
        transpose_item(F.w_out + (size_t)l * D * D, D, D, (f16*)(F.ws + WS_WOUT) + (size_t)l * D * D, scr, r / (D / 32), r % (D / 32), F.lane);
}

DEV void p1_rownorm(Frame& F, const float* xin, f16* h, float* rs) {
    const int gw = F.vcu * NWAVES + F.wave, NGW = F.G * NWAVES;
    for (int row = gw; row < S; row += NGW) {
        const f32x4* xr = (const f32x4*)(xin + (size_t)row * D) + F.lane;
        f32x4 v[16]; float ss = 0.f;
#pragma unroll
        for (int j = 0; j < 16; ++j) { v[j] = xr[64 * j]; ss += (v[j].x * v[j].x + v[j].y * v[j].y) + (v[j].z * v[j].z + v[j].w * v[j].w); }
        ss = wave_sum(ss);
        if (F.lane == 0) rs[row] = 1.0f / sqrtf(ss * (1.0f / D) + EPS);
        u32x2* o = (u32x2*)(h + (size_t)row * D) + F.lane;
#pragma unroll
        for (int j = 0; j < 16; ++j) { u32x2 w; w.x = pk2h(v[j].x, v[j].y); w.y = pk2h(v[j].z, v[j].w); o[64 * j] = w; }
    }
}
DEV void p1_rowscale(Frame& F, const float* ssp, float* rs) {
    for (int row = F.vcu * NTHR + F.tid; row < S; row += F.G * NTHR) {
        const f32x4* p = (const f32x4*)(ssp + (size_t)row * 64); float ss = 0.f;
#pragma unroll
        for (int j = 0; j < 16; ++j) { const f32x4 v = p[j]; ss += (v.x + v.y) + (v.z + v.w); }
        rs[row] = 1.0f / sqrtf(ss * (1.0f / D) + EPS);
    }
}
DEV void rowscale_tile(Frame& F, const float* ssp, float* rs, int pm) {
    if (F.tid < 256) { const int row = pm * 256 + F.tid;
        const f32x4* p = (const f32x4*)(ssp + (size_t)row * 64); float ss = 0.f;
#pragma unroll
        for (int j = 0; j < 16; ++j) { const f32x4 v = p[j]; ss += (v.x + v.y) + (v.z + v.w); }
        rs[row] = 1.0f / sqrtf(ss * (1.0f / D) + EPS); }
    asm volatile("s_waitcnt vmcnt(0)" ::: "memory");
    __syncthreads();
}
DEV void p_final(Frame& F, const f16* xin, const float* g, float* out) {
    const bool grp = F.G == 256;
    const int xg = F.vcu >> 5, gw = grp ? 2048 * xg + NWAVES * (F.vcu & 31) + F.wave : F.vcu * NWAVES + F.wave, NGW = F.G * NWAVES;
    const int nj = grp ? 8 : (gw < S ? (S - gw + NGW - 1) / NGW : 0);
    for (int j = 0; j < nj; ++j) { const int row = grp ? gw + 256 * ((j + xg) & 7) : gw + NGW * j;
        const f16x8* xr = (const f16x8*)(xin + (size_t)row * D) + F.lane;
        f16x8 v[8]; float ss = 0.f;
#pragma unroll
        for (int j = 0; j < 8; ++j) { v[j] = xr[64 * j];
#pragma unroll
            for (int e = 0; e < 8; ++e) ss += (float)v[j][e] * (float)v[j][e]; }
        ss = wave_sum(ss);
        const float rs = 1.0f / sqrtf(ss * (1.0f / D) + EPS);
#pragma unroll
        for (int j = 0; j < 8; ++j) { const int c0 = 8 * (F.lane + 64 * j); const f32x4 g0 = *(const f32x4*)(g + c0), g1 = *(const f32x4*)(g + c0 + 4);
            f32x4 o0, o1; o0.x = (float)v[j][0] * rs * g0.x; o0.y = (float)v[j][1] * rs * g0.y; o0.z = (float)v[j][2] * rs * g0.z; o0.w = (float)v[j][3] * rs * g0.w;
            o1.x = (float)v[j][4] * rs * g1.x; o1.y = (float)v[j][5] * rs * g1.y; o1.z = (float)v[j][6] * rs * g1.z; o1.w = (float)v[j][7] * rs * g1.w;
            *(f32x4*)(out + (size_t)row * D + c0) = o0; *(f32x4*)(out + (size_t)row * D + c0 + 4) = o1; }
    }
}

DEV unsigned offa(unsigned row, unsigned ch) { return 2048u * (row >> 3) + 512u * (ch >> 2) + 64u * (row & 7u) + 16u * ((ch & 3u) ^ ((row >> 2) & 3u)); }
struct Geo { unsigned kb0, kb1, vb0, vb1; };
DEV Geo make_geo(int lane) {
    Geo g; const unsigned r = lane & 31, hh = lane >> 5, Y = (r >> 2) & 3u;
    const unsigned kb = 2048u * (r >> 3) + 64u * (r & 7u);
    g.kb0 = kb + 16u * (2u * (Y >> 1) + (hh ^ (Y & 1u)));
    g.kb1 = kb + 16u * (2u * (1u ^ (Y >> 1)) + (hh ^ (Y & 1u)));
    const unsigned blk = (lane >> 4) & 1, q = (lane & 15) >> 2, p = lane & 3;
    const unsigned vb = 64u * (4u * hh + q) + 8u * (p & 1u) + 16u * ((p >> 1) ^ hh);
    g.vb0 = vb + 32u * blk;
    g.vb1 = vb + 32u * (blk ^ 1u) + 2048u;
    return g;
}
struct Att { f32x16 acc[4]; float m, l; };
DEV void att_init(Att& a) {
#pragma unroll
    for (int c = 0; c < 4; ++c)
#pragma unroll
        for (int i = 0; i < 16; ++i) a.acc[c][i] = 0.f;
    a.m = -1e30f; a.l = 0.f;
}
DEV float half_max(float v) { auto rr = __builtin_amdgcn_permlane32_swap(__float_as_uint(v), __float_as_uint(v), false, false); return fmaxf(__uint_as_float(rr[0]), __uint_as_float(rr[1])); }
DEV float half_sum(float v) { auto rr = __builtin_amdgcn_permlane32_swap(__float_as_uint(v), __float_as_uint(v), false, false); return __uint_as_float(rr[0]) + __uint_as_float(rr[1]); }

struct KFr { f16x8 k[8]; };
struct VFr { s16x4 r[2][4][2]; };
DEV void k_issue(KFr& f, LAS const unsigned char* kt, const Geo& g) {
    const unsigned a0 = (unsigned)(size_t)(kt + g.kb0), a1 = (unsigned)(size_t)(kt + g.kb1);
    asm volatile(
        "ds_read_b128 %0, %8\n\tds_read_b128 %1, %9\n\tds_read_b128 %2, %8 offset:512\n\tds_read_b128 %3, %9 offset:512\n\t"
        "ds_read_b128 %4, %8 offset:1024\n\tds_read_b128 %5, %9 offset:1024\n\tds_read_b128 %6, %8 offset:1536\n\tds_read_b128 %7, %9 offset:1536"
        : "=&v"(f.k[0]), "=&v"(f.k[1]), "=&v"(f.k[2]), "=&v"(f.k[3]), "=&v"(f.k[4]), "=&v"(f.k[5]), "=&v"(f.k[6]), "=&v"(f.k[7])
        : "v"(a0), "v"(a1) : "memory");
}
DEV void k_wait(KFr& f) {
    asm volatile("s_waitcnt lgkmcnt(0)" : "+v"(f.k[0]), "+v"(f.k[1]), "+v"(f.k[2]), "+v"(f.k[3]), "+v"(f.k[4]), "+v"(f.k[5]), "+v"(f.k[6]), "+v"(f.k[7]));
}
DEV void v_issue(VFr& f, LAS const unsigned char* vt, const Geo& g) {
    const unsigned a0 = (unsigned)(size_t)(vt + g.vb0), a1 = (unsigned)(size_t)(vt + g.vb1);
    asm volatile(
        "ds_read_b64_tr_b16 %0, %16\n\tds_read_b64_tr_b16 %1, %17\n\t"
        "ds_read_b64_tr_b16 %2, %16 offset:512\n\tds_read_b64_tr_b16 %3, %17 offset:512\n\t"
        "ds_read_b64_tr_b16 %4, %16 offset:1024\n\tds_read_b64_tr_b16 %5, %17 offset:1024\n\t"
        "ds_read_b64_tr_b16 %6, %16 offset:1536\n\tds_read_b64_tr_b16 %7, %17 offset:1536\n\t"
        "ds_read_b64_tr_b16 %8, %16 offset:4096\n\tds_read_b64_tr_b16 %9, %17 offset:4096\n\t"
        "ds_read_b64_tr_b16 %10, %16 offset:4608\n\tds_read_b64_tr_b16 %11, %17 offset:4608\n\t"
        "ds_read_b64_tr_b16 %12, %16 offset:5120\n\tds_read_b64_tr_b16 %13, %17 offset:5120\n\t"
        "ds_read_b64_tr_b16 %14, %16 offset:5632\n\tds_read_b64_tr_b16 %15, %17 offset:5632"
        : "=&v"(f.r[0][0][0]), "=&v"(f.r[0][0][1]), "=&v"(f.r[0][1][0]), "=&v"(f.r[0][1][1]), "=&v"(f.r[0][2][0]), "=&v"(f.r[0][2][1]), "=&v"(f.r[0][3][0]), "=&v"(f.r[0][3][1]),
          "=&v"(f.r[1][0][0]), "=&v"(f.r[1][0][1]), "=&v"(f.r[1][1][0]), "=&v"(f.r[1][1][1]), "=&v"(f.r[1][2][0]), "=&v"(f.r[1][2][1]), "=&v"(f.r[1][3][0]), "=&v"(f.r[1][3][1])
        : "v"(a0), "v"(a1) : "memory");
}
DEV void v_wait(VFr& f) {
    asm volatile("s_waitcnt lgkmcnt(0)"
        : "+v"(f.r[0][0][0]), "+v"(f.r[0][0][1]), "+v"(f.r[0][1][0]), "+v"(f.r[0][1][1]), "+v"(f.r[0][2][0]), "+v"(f.r[0][2][1]), "+v"(f.r[0][3][0]), "+v"(f.r[0][3][1]),
          "+v"(f.r[1][0][0]), "+v"(f.r[1][0][1]), "+v"(f.r[1][1][0]), "+v"(f.r[1][1][1]), "+v"(f.r[1][2][0]), "+v"(f.r[1][2][1]), "+v"(f.r[1][3][0]), "+v"(f.r[1][3][1]));
}
template <int KS>
DEV f32x16 qk_raw(const KFr& kf, const f16x8 (&qf)[8], const f32x16& sc, int D0p, int hh, unsigned dmax) {
    f32x16 x = __builtin_amdgcn_mfma_f32_32x32x16_f16(kf.k[0], qf[0], sc, 0, 0, 0);
#pragma unroll
    for (int s = 1; s < 8; ++s) x = __builtin_amdgcn_mfma_f32_32x32x16_f16(kf.k[s], qf[s], x, 0, 0, 0);
    const int D0 = D0p + 4 * KS * hh;
    const bool full = __all((D0 - 31 * KS >= 0) && (D0 <= (int)dmax));
    if (!full) {
        const float NEG = -__builtin_inff();
#pragma unroll
        for (int i = 0; i < 16; ++i) { const int ci = (i & 3) + 8 * (i >> 2); const int dist = D0p - KS * ci; x[i] = ((unsigned)dist <= dmax) ? x[i] : NEG; }
    }
    return x;
}
template <int KS> DEV f32x16 make_sc(float sl) { f32x16 sc;
#pragma unroll
    for (int i = 0; i < 16; ++i) sc[i] = sl * (float)(KS * ((i & 3) + 8 * (i >> 2)));
    return sc; }
DEV void pv_mma(Att& st, const VFr& vf, const f32x16& p) {
    u32x4 pw[2];
#pragma unroll
    for (int s = 0; s < 2; ++s)
#pragma unroll
        for (int j = 0; j < 4; ++j) pw[s][j] = __builtin_bit_cast(unsigned, __builtin_amdgcn_cvt_pkrtz(p[8 * s + 2 * j], p[8 * s + 2 * j + 1]));
#pragma unroll
    for (int ks = 0; ks < 2; ++ks)
#pragma unroll
        for (int c = 0; c < 4; ++c) {
            const f16x8 vv = __builtin_shufflevector(__builtin_bit_cast(f16x4, vf.r[ks][c][0]), __builtin_bit_cast(f16x4, vf.r[ks][c][1]), 0, 1, 2, 3, 4, 5, 6, 7);
            st.acc[c] = __builtin_amdgcn_mfma_f32_32x32x16_f16(vv, __builtin_bit_cast(f16x8, pw[ks]), st.acc[c], 0, 0, 0);
        }
}
DEV void att_online(Att& st, LAS const unsigned char* vt, const Geo& g, f32x16 x, float base) {
    float tmax = fmaxf(fmaxf(x[0], x[1]), x[2]);
#pragma unroll
    for (int i = 3; i < 15; i += 2) tmax = fmaxf(fmaxf(tmax, x[i]), x[i + 1]);
    tmax = fmaxf(tmax, x[15]);
    tmax = half_max(tmax + base);
    const float mn = fmaxf(st.m, tmax);
    const float alpha = fexp2(st.m - mn);
    st.m = mn;
    const float nb = base - mn;
    float ps0 = 0.f, ps1 = 0.f;
#pragma unroll
    for (int i = 0; i < 16; i += 2) { x[i] = fexp2(x[i] + nb); x[i + 1] = fexp2(x[i + 1] + nb); ps0 += x[i]; ps1 += x[i + 1]; }
    st.l = st.l * alpha + (ps0 + ps1);
    u32x4 pw[2];
#pragma unroll
    for (int s = 0; s < 2; ++s)
#pragma unroll
        for (int j = 0; j < 4; ++j) pw[s][j] = __builtin_bit_cast(unsigned, __builtin_amdgcn_cvt_pkrtz(x[8 * s + 2 * j], x[8 * s + 2 * j + 1]));
    VFr vf; v_issue(vf, vt, g);
    if (!__all(alpha == 1.0f)) {
#pragma unroll
        for (int c = 0; c < 4; ++c)
#pragma unroll
            for (int i = 0; i < 16; ++i) st.acc[c][i] *= alpha;
    }
    v_wait(vf);
#pragma unroll
    for (int ks = 0; ks < 2; ++ks)
#pragma unroll
        for (int c = 0; c < 4; ++c) {
            const f16x8 vv = __builtin_shufflevector(__builtin_bit_cast(f16x4, vf.r[ks][c][0]), __builtin_bit_cast(f16x4, vf.r[ks][c][1]), 0, 1, 2, 3, 4, 5, 6, 7);
            st.acc[c] = __builtin_amdgcn_mfma_f32_32x32x16_f16(vv, __builtin_bit_cast(f16x8, pw[ks]), st.acc[c], 0, 0, 0);
        }
}
DEV void att_stats(float& m, float& l, const f32x16& x, float base) {
    float tmax = fmaxf(fmaxf(x[0], x[1]), x[2]);
#pragma unroll
    for (int i = 3; i < 15; i += 2) tmax = fmaxf(fmaxf(tmax, x[i]), x[i + 1]);
    tmax = fmaxf(tmax, x[15]);
    tmax = half_max(tmax + base);
    const float mn = fmaxf(m, tmax);
    const float alpha = fexp2(m - mn);
    m = mn;
    const float nb = base - mn;
    float ps0 = 0.f, ps1 = 0.f;
#pragma unroll
    for (int i = 0; i < 16; i += 2) { ps0 += fexp2(x[i] + nb); ps1 += fexp2(x[i + 1] + nb); }
    l = l * alpha + (ps0 + ps1);
}
DEV void load_q(f16x8 (&qf)[8], const f16* qrow  ) {
#pragma unroll
    for (int s = 0; s < 8; ++s) qf[s] = *(const f16x8*)(qrow + 16 * s) * (f16)QSCALE2;
}


DEV float kmax_of(const int* kmx, int slot) { const int* p = kmx + slot * 4; return sqrtf(__int_as_float(p[0]) + __int_as_float(p[1]) + __int_as_float(p[2]) + __int_as_float(p[3])); }
DEV float q_norm(const f16x8 (&qf)[8]) { float s = 0.f;
#pragma unroll
    for (int i = 0; i < 8; ++i)
#pragma unroll
        for (int j = 0; j < 8; ++j) { const float v = (float)qf[i][j]; s += v * v; }
    return sqrtf(half_sum(s)) * 1.001f; }
DEV void slot_rc(int pc, int L, int& row, int& ch) { const int a = pc >> 1, b = (L >> 2) & 7; row = 8 * a + b; const int x = (2 * a + (b >> 2)) & 3; ch = 4 * (2 * (pc & 1) + (L >> 5)) + ((L & 3) ^ x); }
DEV void dma16(const void* g, LAS unsigned char* l) { __builtin_amdgcn_global_load_lds((const unsigned*)g, (LAS unsigned*)l, 16, 0, 0); }
#define WAITV_BAR(n) do { asm volatile("s_waitcnt vmcnt(" #n ") lgkmcnt(0)" ::: "memory"); __builtin_amdgcn_s_barrier(); asm volatile("" ::: "memory"); } while (0)

DEV float gelu_tanh(float v) { const float u = 0.7978845608028654f * (v + 0.044715f * v * v * v); const float e = fexp2(-2.0f * LOG2E * u); return v / (1.0f + e); }
DEV void cmp_unit(Frame& F, int cu, int layer) {
    const int kv = cu & 1, g = (cu >> 1) & 1, ct = cu >> 2;
    const int lane = F.lane, w = F.wave, r = lane & 31, hh = lane >> 5;
    const f16* proj = (const f16*)(F.ws + WS_PROJ);
    const float* pe = (kv ? F.v_pe : F.k_pe) + (size_t)layer * 32 * 128;
    const f16* W1t = (const f16*)(F.ws + WS_W1) + (size_t)(layer * 2 + kv) * 256 * 4096;
    const f16* W2t = (const f16*)(F.ws + WS_W2) + (size_t)(layer * 2 + kv) * 128 * 256;
    LAS float* accb = (LAS float*)F.lds;
    LAS f16* hid = (LAS f16*)(F.lds + 32768);
    const int c = 32 * ct + r; const int colbase = (kv ? C_VC : C_KC) + g * 128;
    f32x16 acc[8];
#pragma unroll
    for (int n = 0; n < 8; ++n)
#pragma unroll
        for (int i = 0; i < 16; ++i) acc[n][i] = 0.f;
#pragma unroll 2
    for (int s = 0; s < 32; ++s) {
        const int l = 4 * w + (s >> 3), dd = 16 * (s & 7) + 8 * hh;
        int tok = 16 * c + l; tok = tok < S ? tok : S - 1;
        const f16x8 xv = *(const f16x8*)(proj + (size_t)tok * NINP + colbase + dd);
        const f32x4 p0 = *(const f32x4*)(pe + l * 128 + dd), p1 = *(const f32x4*)(pe + l * 128 + dd + 4);
        f16x8 af;
        af[0] = (f16)((float)xv[0] + p0.x); af[1] = (f16)((float)xv[1] + p0.y); af[2] = (f16)((float)xv[2] + p0.z); af[3] = (f16)((float)xv[3] + p0.w);
        af[4] = (f16)((float)xv[4] + p1.x); af[5] = (f16)((float)xv[5] + p1.y); af[6] = (f16)((float)xv[6] + p1.z); af[7] = (f16)((float)xv[7] + p1.w);
        const int kk = l * 128 + dd;
#pragma unroll
        for (int n = 0; n < 8; ++n) { const f16x8 bf = *(const f16x8*)(W1t + (size_t)(32 * n + r) * 4096 + kk); acc[n] = __builtin_amdgcn_mfma_f32_32x32x16_f16(af, bf, acc[n], 0, 0, 0); }
    }
    for (int ww = 0; ww < 8; ++ww) {
        if (w == ww) {
#pragma unroll
            for (int n = 0; n < 8; ++n)
#pragma unroll
                for (int i = 0; i < 16; ++i) { const int cr = (i & 3) + 8 * (i >> 2) + 4 * hh; LAS float* p = accb + cr * 256 + 32 * n + r; *p = (ww == 0) ? acc[n][i] : (*p + acc[n][i]); }
        }
        __syncthreads();
    }
    for (int e = F.tid; e < 32 * 256; e += NTHR) { const int cr = e >> 8, n = e & 255; hid[cr * 264 + n] = (f16)gelu_tanh(accb[e]); }
    __syncthreads();
    if (w < 4) {
        f32x16 o;
#pragma unroll
        for (int i = 0; i < 16; ++i) o[i] = 0.f;
#pragma unroll
        for (int s = 0; s < 16; ++s) { const f16x8 af = *(const LAS f16x8*)(hid + r * 264 + 16 * s + 8 * hh); const f16x8 bf = *(const f16x8*)(W2t + (size_t)(32 * w + r) * 256 + 16 * s + 8 * hh);
            o = __builtin_amdgcn_mfma_f32_32x32x16_f16(af, bf, o, 0, 0, 0); }
        f16* outp = (f16*)(F.ws + WS_CMP) + (size_t)((kv * 2 + g) * 1024) * 128;
#pragma unroll
        for (int i = 0; i < 16; ++i) { const int cr = (i & 3) + 8 * (i >> 2) + 4 * hh; const int cc = 32 * ct + cr; outp[(size_t)cc * 128 + 32 * w + r] = (cc < 1023) ? (f16)o[i] : (f16)0.f; }
        if (kv == 0) {
            float pm = 0.f;
#pragma unroll
            for (int i = 0; i < 16; ++i) { float sq = o[i] * o[i];
#pragma unroll
                for (int sh = 1; sh < 32; sh <<= 1) sq += __shfl_xor(sq, sh);
                pm = fmaxf(pm, sq); }
            pm = fmaxf(pm, __shfl_xor(pm, 32));
            if (lane == 0) atomicMax((int*)(F.ws + WS_CTL) + CW_KMX + layer * 96 + (20 + g) * 4 + w, __float_as_int(pm * 1.004f));
        }
    }
    asm volatile("s_waitcnt vmcnt(0)" ::: "memory");
    __syncthreads();
    if (F.tid == 0) { __builtin_amdgcn_fence(__ATOMIC_RELEASE, "agent"); asm volatile("s_waitcnt vmcnt(0)" ::: "memory"); (void)xb_add((unsigned*)(F.ws + WS_CTL) + CW_CMPD + 64 * layer, 1u); }
}

DEV const f16* a_unit_qrow(Frame& F, int u) {
    const int hp = u / 384, rem = u % 384, p = rem >> 7, nb = rem & 127;
    const int dsh = 2 * p, dil = 1 << dsh, nbr = 128 >> dsh, rr = nb / nbr, n = nb % nbr;
    const int half = F.wave >> 2, wq = (F.wave & 4) ? 3 - (F.wave & 3) : (F.wave & 3), ql = F.lane & 31, hh = F.lane >> 5;
    const int qsub = 128 * n + 32 * wq + ql, tq = qsub * dil + rr;
    return (const f16*)(F.ws + WS_PROJ) + (size_t)tq * NINP + C_QA + (2 * hp + half) * 128 + 8 * hh;
}
DEV void attn_a_unit(Frame& F, int u, f16x8 (&qf)[8], int un, int layer) {
    const int hp = u / 384, rem = u % 384, p = rem >> 7, nb = rem & 127;
    const int dsh = 2 * p, dil = 1 << dsh, nbr = 128 >> dsh;
    const int rr = nb / nbr, n = nb % nbr;
    const int lane = F.lane, half = F.wave >> 2, wq = (F.wave & 4) ? 3 - (F.wave & 3) : (F.wave & 3), ql = lane & 31, hh = lane >> 5;
    const int head = 2 * hp + half;
    const f16* proj = (const f16*)(F.ws + WS_PROJ);
    const int qsub = 128 * n + 32 * wq + ql, tq = qsub * dil + rr;
    const float sl = fexp2(-0.5f * (float)(head + 1)) * (float)dil * LOG2E;
    const unsigned dmax = (unsigned)(qsub < 128 ? qsub : 128);
    const Geo g = make_geo(lane);
    const f32x16 sc = make_sc<1>(sl);
    const float bq = q_norm(qf) * kmax_of((const int*)(F.ws + WS_CTL) + CW_KMX + layer * 96, head) + sl * 31.0f;
    Att st; att_init(st);
    LAS unsigned char* base = F.lds + half * 65536;
    int r0, c0, r1, c1; slot_rc(2 * wq, lane, r0, c0); slot_rc(2 * wq + 1, lane, r1, c1);
    const int ksub0 = 128 * (n - 1);
    const f16* colb = proj + head * 128;
#define A_ISSUE(I) do { const int Jc = (I) < 4 ? 3 - (I) : 0; LAS unsigned char* sb_ = base + ((I) & 1) * 32768 + wq * 2048; \
        _Pragma("unroll") for (int sub_ = 0; sub_ < 2; ++sub_) { \
        int s0 = ksub0 + 64 * Jc + 32 * sub_ + r0, s1 = ksub0 + 64 * Jc + 32 * sub_ + r1; s0 = s0 < 0 ? 0 : s0; s1 = s1 < 0 ? 0 : s1; \
        const f16* g0 = colb + (size_t)(s0 * dil + rr) * NINP + c0 * 8; const f16* g1 = colb + (size_t)(s1 * dil + rr) * NINP + c1 * 8; \
        dma16(g0 + C_KA, sb_ + sub_ * 16384); dma16(g1 + C_KA, sb_ + sub_ * 16384 + 1024); dma16(g0 + C_VA, sb_ + sub_ * 16384 + 8192); dma16(g1 + C_VA, sb_ + sub_ * 16384 + 8192 + 1024); } } while (0)
    A_ISSUE(0);
#pragma nounroll
    for (int i = 0; i < 4; ++i) {
        WAITV_BAR(0);
        A_ISSUE(i + 1);
#pragma unroll
        for (int sub = 1; sub >= 0; --sub) {
            const int T = 2 * (3 - i) + sub;
            const int D0p = 128 + 32 * (wq - T) + ql - 4 * hh;
            if (T >= wq && T <= wq + 4 && !__all(bq - sl * (float)D0p - st.m < SKIP_LOG2)) {
                LAS unsigned char* sb = base + (i & 1) * 32768 + sub * 16384;
                KFr kf; k_issue(kf, sb, g); k_wait(kf);
                const f32x16 x = qk_raw<1>(kf, qf, sc, D0p, hh, dmax);
                att_online(st, sb + 8192, g, x, -sl * (float)D0p);
            }
        }
    }
#undef A_ISSUE
    asm volatile("s_waitcnt vmcnt(0)" ::: "memory");
    if (un >= 0) load_q(qf, a_unit_qrow(F, un));
    const float lt = half_sum(st.l);
    const float inv = 1.0f / lt;
    f16* oa = (f16*)(F.ws + WS_OA) + ((size_t)p * S + tq) * DA + head * 128;
#pragma unroll
    for (int c = 0; c < 4; ++c)
#pragma unroll
        for (int gq = 0; gq < 4; ++gq) { u32x2 w; w.x = pk2h(st.acc[c][4 * gq] * inv, st.acc[c][4 * gq + 1] * inv); w.y = pk2h(st.acc[c][4 * gq + 2] * inv, st.acc[c][4 * gq + 3] * inv);
            *(u32x2*)(oa + 32 * c + 8 * gq + 4 * hh) = w; }
    if (hh == 0) ((float*)(F.ws + WS_LSE))[((size_t)p * S + tq) * 16 + head] = st.m + __builtin_amdgcn_logf(lt);
    asm volatile("s_waitcnt lgkmcnt(0)" ::: "memory"); __builtin_amdgcn_s_barrier(); asm volatile("" ::: "memory");
}

constexpr int NSA_NS = 5;
DEV void nsa_unit(Frame& F, int chunk, int gq, int layer) {
    const int lane = F.lane, w = F.wave, ql = lane & 31, hh = lane >> 5, tid = F.tid;
    const int hw = w < 4 ? w : 11 - w;
    const int t0 = 32 * chunk, t = t0 + ql, head = 8 * gq + hw, cur = t0 >> 6;
    const f16* proj = (const f16*)(F.ws + WS_PROJ);
    f16x8 qf[8]; load_q(qf, proj + (size_t)t * NINP + C_QB + head * 128 + 8 * hh);
    const float sl = fexp2(-0.5f * (float)(head + 1)) * LOG2E;
    const Geo g = make_geo(lane);
    LAS unsigned char* tiles = F.lds;
    LAS float* imp = (LAS float*)(F.lds + 81920);
    LAS float* part = (LAS float*)(F.lds + 114688);
    LAS float* carry = (LAS float*)(F.lds + 147456);
    LAS unsigned* sel = (LAS unsigned*)(F.lds + 147456 + 256);
    LAS unsigned* uni = sel + 256;
    LAS unsigned* blist = sel + 272;
    int lr, lch; slot_rc(w, lane, lr, lch);
    LAS unsigned char* mypiece = tiles + w * 1024;
    f16* ob = (f16*)(F.ws + WS_OB) + (size_t)t * DB + head * 128;
#define NSA_STORE(br, scale) do { f16* _o = ob + (size_t)(br) * S * DB; const float _s = (scale); \
        _Pragma("unroll") for (int c = 0; c < 4; ++c) _Pragma("unroll") for (int gg = 0; gg < 4; ++gg) { u32x2 wv; wv.x = pk2h(st.acc[c][4 * gg] * _s, st.acc[c][4 * gg + 1] * _s); wv.y = pk2h(st.acc[c][4 * gg + 2] * _s, st.acc[c][4 * gg + 3] * _s); \
            *(u32x2*)(_o + 32 * c + 8 * gg + 4 * hh) = wv; } } while (0)

    const f16* kwb = proj + C_KW + gq * 128 + (size_t)lr * NINP + lch * 8; const f16* vwb = proj + C_VW + gq * 128 + (size_t)lr * NINP + lch * 8;
    const int Tl = (t0 >> 5); const int Tf = Tl >= 16 ? Tl - 16 : 0; const int nw = Tl - Tf + 1;
#define W_ISSUE(I) do { LAS unsigned char* sb_ = mypiece + ((I) & 1) * 32768; \
        _Pragma("unroll") for (int sub_ = 0; sub_ < 2; ++sub_) { int tt_ = Tl - 2 * (I) - (1 - sub_); tt_ = tt_ < Tf ? Tf : tt_; const size_t ro = (size_t)(32 * tt_) * NINP; \
            dma16(kwb + ro, sb_ + sub_ * 16384); dma16(vwb + ro, sb_ + sub_ * 16384 + 8192); } } while (0)
    const f16* kc = (const f16*)(F.ws + WS_CMP) + (size_t)((0 * 2 + gq) * 1024) * 128 + (size_t)lr * 128 + lch * 8;
    const f16* vc = (const f16*)(F.ws + WS_CMP) + (size_t)((1 * 2 + gq) * 1024) * 128 + (size_t)lr * 128 + lch * 8;
    const int ntc = (t0 >> 9) + 1;
    const f32x16 sc16 = make_sc<16>(sl);
    const float qn = q_norm(qf); const int* kmx = (const int*)(F.ws + WS_CTL) + CW_KMX + layer * 96;
    const float bqC = qn * kmax_of(kmx, 20 + gq) + sl * 16.0f * 31.0f;
    float m_c = -1e30f, l_c = 0.f;
#define C1_ISSUE(I) do { const int Tc = (I) < ntc ? ntc - 1 - (I) : 0; dma16(kc + (size_t)Tc * 4096, mypiece + ((I) % NSA_NS) * 16384); } while (0)
    C1_ISSUE(0); C1_ISSUE(1); C1_ISSUE(2); C1_ISSUE(3);
#pragma nounroll
    for (int I = 0; I < ntc; ++I) {
        WAITV_BAR(3);
        const int T = ntc - 1 - I;
        const int D0p = t - 31 - 512 * T - 64 * hh;
        const bool skip = __all(bqC - sl * (float)D0p - m_c < SKIP_LOG2);
        C1_ISSUE(I + 4);
        if (!skip) {
            KFr kf; k_issue(kf, tiles + (I % NSA_NS) * 16384, g); k_wait(kf);
            const f32x16 x = qk_raw<16>(kf, qf, sc16, D0p, hh, 1u << 30);
            att_stats(m_c, l_c, x, -sl * (float)D0p);
        }
    }
#undef C1_ISSUE
    l_c = half_sum(l_c);
    const float invl_c = l_c > 0.f ? 1.0f / l_c : 0.f;
    WAITV_BAR(0);
    {
        Att st; att_init(st);
#define C2_ISSUE(T) do { const int Tc = (T) < ntc ? (T) : ntc - 1; LAS unsigned char* sb_ = mypiece + ((T) % NSA_NS) * 16384; dma16(kc + (size_t)Tc * 4096, sb_); dma16(vc + (size_t)Tc * 4096, sb_ + 8192); } while (0)
#define C2_REDUCE(tau) do { const LAS float* pp = part + ((tau) & 1) * 4096; const int q = tid >> 4, k = (tid >> 1) & 7, wh = tid & 1; float sred = 0.f; \
        _Pragma("unroll") for (int ww = 0; ww < 8; ++ww) sred += pp[((ww * 32 + q) * 8 + k) * 2 + wh]; \
        const float up = __shfl_up(sred, 1); \
        if (wh == 0) { const float add = k >= 1 ? up : ((tau) >= 1 ? carry[(((tau) - 1) & 1) * 32 + q] : 0.f); imp[q * 256 + 8 * (tau) + k] = sred + add; } \
        else if (k == 7) carry[((tau) & 1) * 32 + q] = sred; } while (0)
        C2_ISSUE(0); C2_ISSUE(1); C2_ISSUE(2); C2_ISSUE(3);
        int T0w = 0;
        while (T0w < ntc && __all(bqC - sl * (float)(t - 31 - 512 * T0w - 64 * hh) - m_c < SKIP_LOG2)) ++T0w;
#pragma nounroll
        for (int T = 0; T < T0w; ++T) {
            WAITV_BAR(6);
            C2_ISSUE(T + 4);
            if (T > 0) C2_REDUCE(T - 1);
            LAS float* pw = part + (T & 1) * 4096 + (w * 32 + ql) * 16;
#pragma unroll
            for (int gg = 0; gg < 4; ++gg) *(LAS f32x2*)(pw + (2 * gg + hh) * 2) = (f32x2){0.f, 0.f};
        }
#pragma nounroll
        for (int T = T0w; T < ntc; ++T) {
            WAITV_BAR(6);
            LAS unsigned char* sb = tiles + (T % NSA_NS) * 16384;
            KFr kf; k_issue(kf, sb, g);
            C2_ISSUE(T + 4);
            if (T > 0) C2_REDUCE(T - 1);
            k_wait(kf);
            const int D0p = t - 31 - 512 * T - 64 * hh;
            f32x16 x = qk_raw<16>(kf, qf, sc16, D0p, hh, 1u << 30);
            VFr vf; v_issue(vf, sb + 8192, g);
            const float nb = -sl * (float)D0p - m_c;
#pragma unroll
            for (int i = 0; i < 16; ++i) x[i] = fexp2(x[i] + nb) * invl_c;
            LAS float* pw = part + (T & 1) * 4096 + (w * 32 + ql) * 16;
#pragma unroll
            for (int gg = 0; gg < 4; ++gg) { f32x2 v; v.x = (x[4 * gg] + x[4 * gg + 1]) + (x[4 * gg + 2] + x[4 * gg + 3]); v.y = x[4 * gg + 3]; *(LAS f32x2*)(pw + (2 * gg + hh) * 2) = v; }
            v_wait(vf);
            pv_mma(st, vf, x);
        }
        WAITV_BAR(0);
        C2_REDUCE(ntc - 1);
#undef C2_ISSUE
#undef C2_REDUCE
        W_ISSUE(0);
        NSA_STORE(0, 1.0f);
        WAITV_BAR(63);
    }
    for (int qi = 0; qi < 4; ++qi) {
        const int qq = 4 * w + qi;
        unsigned selm = 0u;
        if (cur <= 15) {
#pragma unroll
            for (int m = 0; m < 4; ++m) if (lane + 64 * m <= cur) selm |= 1u << m;
        } else {
            int sv[4];
#pragma unroll
            for (int m = 0; m < 4; ++m) { const int j = lane + 64 * m; sv[m] = (j >= 1 && j <= cur - 2) ? __float_as_int(imp[qq * 256 + j]) : -1; }
            int thr = 0;
#pragma nounroll
            for (int bit = 30; bit >= 0; --bit) {
                const int cand = thr | (1 << bit);
                const int cnt = __popcll(__ballot(sv[0] >= cand)) + __popcll(__ballot(sv[1] >= cand)) + __popcll(__ballot(sv[2] >= cand)) + __popcll(__ballot(sv[3] >= cand));
                thr = cnt >= 13 ? cand : thr;
            }
            int cgt = 0;
#pragma unroll
            for (int m = 0; m < 4; ++m) { const bool gt = sv[m] > thr; cgt += __popcll(__ballot(gt)); if (gt) selm |= 1u << m; }
            const int need = 13 - cgt; int before = 0;
#pragma unroll
            for (int m = 0; m < 4; ++m) { const bool eq = sv[m] == thr; const unsigned long long em = __ballot(eq);
                const int rank = before + (int)__builtin_amdgcn_mbcnt_hi((unsigned)(em >> 32), __builtin_amdgcn_mbcnt_lo((unsigned)em, 0u));
                if (eq && rank < need) selm |= 1u << m; before += __popcll(em); }
#pragma unroll
            for (int m = 0; m < 4; ++m) { const int j = lane + 64 * m; if (j == 0 || j == cur || j == cur - 1) selm |= 1u << m; }
        }
#pragma unroll
        for (int m = 0; m < 4; ++m) { const unsigned long long b = __ballot((selm >> m) & 1u); if (lane == 0) { sel[qq * 8 + 2 * m] = (unsigned)b; sel[qq * 8 + 2 * m + 1] = (unsigned)(b >> 32); } }
    }
    WAITV_BAR(63);
    if (w == 0) {
        unsigned o = 0u;
        if (lane < 8) { for (int q = 0; q < 32; ++q) o |= sel[q * 8 + lane]; }
        const int pc = __popc(o); int pre = 0;
#pragma unroll
        for (int k = 0; k < 7; ++k) { const int pk = __shfl(pc, k); if (lane > k) pre += pk; }
        if (lane < 8) { unsigned wv = o; int pos = pre; while (wv) { const int b = __builtin_ctz(wv); wv &= wv - 1; blist[pos++] = (unsigned)(32 * lane + b); } }
        if (lane == 7) uni[8] = (unsigned)(pre + pc);
    }
    WAITV_BAR(63);
    const f32x16 sc1 = make_sc<1>(sl);
    const float bqS = qn * kmax_of(kmx, 16 + gq) + sl * 31.0f, bqW = qn * kmax_of(kmx, 18 + gq) + sl * 31.0f;
    const f16* ksb = proj + C_KS + gq * 128 + (size_t)lr * NINP + lch * 8; const f16* vsb = proj + C_VS + gq * 128 + (size_t)lr * NINP + lch * 8;
    const int nblk = (int)uni[8];
#define S_ISSUE(I) do { const int b_ = (int)blist[(I) < nblk ? nblk - 1 - (I) : 0]; LAS unsigned char* sb_ = F.lds + 81920 + w * 1024 + ((I) & 1) * 32768; \
        _Pragma("unroll") for (int sub_ = 0; sub_ < 2; ++sub_) { const size_t ro = (size_t)(64 * b_ + 32 * sub_) * NINP; dma16(ksb + ro, sb_ + sub_ * 16384); dma16(vsb + ro, sb_ + sub_ * 16384 + 8192); } } while (0)
    S_ISSUE(0);
    {
        Att st; att_init(st);
#pragma nounroll
        for (int i = 0; 2 * i < nw; ++i) {
            WAITV_BAR(0);
            W_ISSUE(i + 1);
#pragma unroll
            for (int sub = 1; sub >= 0; --sub) {
                const int Tt = Tl - 2 * i - (1 - sub);
                const int D0p = t - 32 * Tt - 4 * hh;
                if (Tt >= Tf && !__all(bqW - sl * (float)D0p - st.m < SKIP_LOG2)) {
                    LAS unsigned char* sb = tiles + (i & 1) * 32768 + sub * 16384;
                    KFr kf; k_issue(kf, sb, g); k_wait(kf);
                    const f32x16 x = qk_raw<1>(kf, qf, sc1, D0p, hh, 511u);
                    att_online(st, sb + 8192, g, x, -sl * (float)D0p);
                }
            }
        }
#undef W_ISSUE
        const float lt = half_sum(st.l);
        NSA_STORE(2, 1.0f / lt);
    }
    {
        Att st; att_init(st);
        LAS unsigned char* tilesB = F.lds + 81920;
#pragma nounroll
        for (int i = 0; i < nblk; ++i) {
            WAITV_BAR(0);
            S_ISSUE(i + 1);
            const int b = (int)blist[nblk - 1 - i];
            const bool ok = (sel[ql * 8 + (b >> 5)] >> (b & 31)) & 1u;
#pragma unroll
            for (int sub = 1; sub >= 0; --sub) {
                const int kb = 64 * b + 32 * sub;
                const int D0p = t - kb - 4 * hh; const float bs = ok ? -sl * (float)D0p : -__builtin_inff();
                if (kb <= t0 + 31 && !__all(bqS + bs - st.m < SKIP_LOG2)) {
                    LAS unsigned char* sb = tilesB + (i & 1) * 32768 + sub * 16384;
                    KFr kf; k_issue(kf, sb, g); k_wait(kf);
                    const f32x16 x = qk_raw<1>(kf, qf, sc1, D0p, hh, 1u << 30);
                    att_online(st, sb + 8192, g, x, bs);
                }
            }
        }
#undef S_ISSUE
        asm volatile("s_waitcnt vmcnt(0)" ::: "memory");
        const float lt = half_sum(st.l);
        NSA_STORE(1, 1.0f / lt);
    }
#undef NSA_STORE
    WAITV_BAR(63);
}

struct P5Item { f16x8 a0[4], a1[4], a2[4], z[4]; float s0[4], s1[4], s2[4]; };
DEV void p5_load(Frame& F, P5Item& it, int item) {
    const int t = item >> 1, sideB = item & 1, lane = F.lane;
    const f16* proj = (const f16*)(F.ws + WS_PROJ) + (size_t)t * NINP;
    const f16* src = (const f16*)(F.ws + (sideB ? WS_OB : WS_OA)) + (size_t)t * DA;
    const float* lse = (const float*)(F.ws + WS_LSE) + (size_t)t * 16;
#pragma unroll
    for (int k = 0; k < 4; ++k) {
        const int col0 = 512 * k + 8 * lane, head = col0 >> 7;
        it.a0[k] = *(const f16x8*)(src + col0); it.a1[k] = *(const f16x8*)(src + (size_t)S * DA + col0); it.a2[k] = *(const f16x8*)(src + (size_t)2 * S * DA + col0);
        it.z[k] = *(const f16x8*)(proj + (sideB ? C_ZB : C_ZA) + col0);
        if (sideB) { const f16* gp = proj + C_GT + 3 * head; it.s0[k] = (float)gp[0]; it.s1[k] = (float)gp[1]; it.s2[k] = (float)gp[2]; }
        else { it.s0[k] = lse[head]; it.s1[k] = lse[(size_t)S * 16 + head]; it.s2[k] = lse[(size_t)2 * S * 16 + head]; }
    }
}
DEV void p5_compute(Frame& F, const P5Item& it, int item, int layer) {
    const int t = item >> 1, sideB = item & 1, lane = F.lane;
    const float* gg = (sideB ? F.og_b : F.og_a) + (size_t)layer * DA;
    float o[4][8]; float ss = 0.f;
#pragma unroll
    for (int k = 0; k < 4; ++k) {
        float w0, w1, w2;
        if (sideB) { w0 = 1.0f / (1.0f + fexp2(-LOG2E * it.s0[k])); w1 = 1.0f / (1.0f + fexp2(-LOG2E * it.s1[k])); w2 = 1.0f / (1.0f + fexp2(-LOG2E * it.s2[k])); }
        else { const float mx = fmaxf(it.s0[k], fmaxf(it.s1[k], it.s2[k])); w0 = fexp2(it.s0[k] - mx); w1 = fexp2(it.s1[k] - mx); w2 = fexp2(it.s2[k] - mx); const float inv = 1.0f / (w0 + w1 + w2); w0 *= inv; w1 *= inv; w2 *= inv; }
#pragma unroll
        for (int j = 0; j < 8; ++j) { o[k][j] = w0 * (float)it.a0[k][j] + w1 * (float)it.a1[k][j] + w2 * (float)it.a2[k][j]; ss += o[k][j] * o[k][j]; }
    }
    ss = wave_sum(ss);
    const float rs = 1.0f / sqrtf(ss * (1.0f / DA) + EPS);
    f16* y = (f16*)(F.ws + WS_Y) + (size_t)t * D + (sideB ? DA : 0);
#pragma unroll
    for (int k = 0; k < 4; ++k) {
        const int col0 = 512 * k + 8 * lane;
        const f32x4 g0 = *(const f32x4*)(gg + col0), g1 = *(const f32x4*)(gg + col0 + 4);
        float r[8];
#pragma unroll
        for (int j = 0; j < 8; ++j) { const float zz = (float)it.z[k][j]; const float gv = j < 4 ? g0[j & 3] : g1[j & 3]; r[j] = o[k][j] * rs * gv * (zz / (1.0f + fexp2(-LOG2E * zz))); }
        u32x4 wv; wv.x = pk2h(r[0], r[1]); wv.y = pk2h(r[2], r[3]); wv.z = pk2h(r[4], r[5]); wv.w = pk2h(r[6], r[7]);
        *(u32x4*)(y + col0) = wv;
    }
}
DEV void p5_finalize(Frame& F, int layer) {
    const bool grp = F.G == 256;
    const int xg = F.vcu >> 5, gw = grp ? 2048 * xg + NWAVES * (F.vcu & 31) + F.wave : F.vcu * NWAVES + F.wave, NGW = F.G * NWAVES;
    const int nj = grp ? 8 : (gw < S ? (S - gw + NGW - 1) / NGW : 0);
#define P5_ROW(j) (grp ? gw + 256 * (((j) + xg) & 7) : gw + NGW * (j))
    P5Item ia, ib;
    if (nj > 0) p5_load(F, ia, 2 * P5_ROW(0));
#pragma nounroll
    for (int j = 0; j < nj; ++j) {
        const int t = P5_ROW(j);
        p5_load(F, ib, 2 * t + 1);
        p5_compute(F, ia, 2 * t, layer);
        const int tn = j + 1 < nj ? P5_ROW(j + 1) : t;
        p5_load(F, ia, 2 * tn);
        p5_compute(F, ib, 2 * t + 1, layer);
    }
#undef P5_ROW
}

struct Args { const float* in[13]; float* out; unsigned char* ws; int ph_lo, ph_hi, fused, pad; };
constexpr int N_PHASES = 2 + 6 * DEPTH;

__global__ void __launch_bounds__(NTHR, 2) mega_fwd(Args args) {
    extern __shared__ __attribute__((aligned(16))) unsigned char lds_raw[];
    Frame F;
    F.lds = (LAS unsigned char*)lds_raw;
    F.tid = threadIdx.x; F.lane = F.tid & 63; F.wave = __builtin_amdgcn_readfirstlane(F.tid >> 6);
    F.G = gridDim.x; { const int bx = blockIdx.x; F.vcu = (F.G % 8 == 0) ? (bx % 8) * (F.G / 8) + bx / 8 : bx; }
    F.x = args.in[0]; F.norm_g = args.in[1]; F.w_in = args.in[2]; F.k_pe = args.in[3]; F.k_w1 = args.in[4]; F.k_w2 = args.in[5];
    F.v_pe = args.in[6]; F.v_w1 = args.in[7]; F.v_w2 = args.in[8]; F.og_a = args.in[9]; F.og_b = args.in[10]; F.w_out = args.in[11]; F.fin_g = args.in[12];
    F.out = args.out; F.ws = args.ws;
    volatile LAS unsigned* MISC = (volatile LAS unsigned*)(F.lds + MISC_OFF);
    if (F.tid < 32) MISC[F.tid] = 0u;
    __syncthreads();
    const bool fused = args.fused != 0;
    XcdBarrier bar; bar.bar = (unsigned*)(F.ws + WS_CTL) + CW_BAR; bar.x = 0; bar.st = nullptr;
    if (fused) bar = xcd_barrier_post((unsigned*)(F.ws + WS_CTL) + CW_BAR, MISC + 8);
    const int lo = args.ph_lo, hi = args.ph_hi;
    const bool grouped = F.G == 256;
    unsigned* gcnt = (unsigned*)(F.ws + WS_CTL) + CW_GRP + 64 * (F.vcu >> 5);
#define IN(k) (lo <= (k) && (k) < hi)
#define RETID() do { int _t = threadIdx.x; asm volatile("" : "+v"(_t)); F.tid = _t; F.lane = _t & 63; F.wave = __builtin_amdgcn_readfirstlane(_t >> 6); } while (0)
#define SEAM(k) do { if (fused && IN((k) + 1)) xcd_barrier(bar); } while (0)

    if (IN(0)) { RETID(); p0_prologue(F); SEAM(0); }

    for (int l = 0; l < DEPTH; ++l) {
        const int pb = 1 + 6 * l;
        if (IN(pb + 0)) { RETID(); if (l == 0) { p1_rownorm(F, F.x, (f16*)(F.ws + WS_H), (float*)(F.ws + WS_RS)); SEAM(pb + 0); } else if (!grouped) { p1_rowscale(F, (const float*)(F.ws + WS_RSP), (float*)(F.ws + WS_RS)); SEAM(pb + 0); } }
        if (IN(pb + 1)) {
            pg8::Gemm g{(const f16*)(F.ws + WS_H), (const f16*)(F.ws + WS_WIN) + (size_t)l * NINP * D, S, NINP, D};
            pg8::StaticOrder So; So.init(S, NINP, F.G, (int)blockIdx.x);
            pg8::EpiF16 E{(f16*)(F.ws + WS_PROJ), NINP, (const float*)(F.ws + WS_RS), (int*)(F.ws + WS_CTL) + CW_KMX + l * 96};
            if (grouped && l > 0) { RETID(); rowscale_tile(F, (const float*)(F.ws + WS_RSP), (float*)(F.ws + WS_RS), 8 * (F.vcu >> 5) + (F.vcu & 7)); }
            pg8::gemm_phase<pg8::EpiF16, pg8::StaticOrder, true, true>(F.lds, g, So, E);
            RETID(); backfill_wout(F, l);
            SEAM(pb + 1);
        }
        if (IN(pb + 2)) {
            const bool hasc = F.vcu < 128 && F.G == 256;
            if (F.G == 256) {
                if (hasc) { RETID(); cmp_unit(F, F.vcu, l); }
                RETID(); f16x8 qf[8]; load_q(qf, a_unit_qrow(F, F.vcu));
                constexpr int NC = 9;
                const int nu = hasc ? NC : 24 - NC;
                for (int k = 0; k < nu; ++k) {
                    const int u = k < 12 ? F.vcu + 256 * k : F.vcu - 128 + 256 * (NC + k - 12);
                    const int k1 = k + 1; const int un = k1 < nu ? (k1 < 12 ? F.vcu + 256 * k1 : F.vcu - 128 + 256 * (NC + k1 - 12)) : -1;
                    attn_a_unit(F, u, qf, un, l);
                }
            } else {
                for (int u = F.vcu; u < 128; u += F.G) { RETID(); cmp_unit(F, u, l); }
                RETID(); f16x8 qf[8]; load_q(qf, a_unit_qrow(F, F.vcu < 3072 ? F.vcu : 0));
                for (int u = F.vcu; u < 3072; u += F.G) { const int un = u + F.G < 3072 ? u + F.G : -1; attn_a_unit(F, u, qf, un, l); }
            }
        }
        if (IN(pb + 3)) {
            if (F.tid == 0) { unsigned* cd = (unsigned*)(F.ws + WS_CTL) + CW_CMPD + 64 * l; XB_SPIN(xb_ld(cd) < 128u, bar.bar); __builtin_amdgcn_fence(__ATOMIC_ACQUIRE, "agent"); asm volatile("s_waitcnt vmcnt(0)" ::: "memory"); }
            __syncthreads();
            for (int idx = F.vcu; idx < 1024; idx += F.G) {
                const int gq = (idx ^ (idx >> 8) ^ (idx >> 9)) & 1, k = idx >> 1, kq = k & 127, ki = k >> 7;
                const int chunk = ki == 0 ? kq : (ki == 1 ? 255 - kq : (ki == 2 ? 256 + kq : 511 - kq));
                RETID(); nsa_unit(F, chunk, gq, l);
            }
            SEAM(pb + 3);
        }
        if (IN(pb + 4)) { RETID(); p5_finalize(F, l); if (grouped) { if (fused && IN(pb + 5)) group_barrier(gcnt, 32u, bar.bar); } else SEAM(pb + 4); }
        if (IN(pb + 5)) {
            pg8::Gemm g{(const f16*)(F.ws + WS_Y), (const f16*)(F.ws + WS_WOUT) + (size_t)l * D * D, S, D, D};
            pg8::StaticOrder So; So.init(S, D, F.G, (int)blockIdx.x);
            pg8::EpiRes E{(f16*)(F.ws + WS_H), D, (l + 1 < DEPTH) ? (float*)(F.ws + WS_RSP) : nullptr};
            pg8::gemm_phase<pg8::EpiRes, pg8::StaticOrder, true, true>(F.lds, g, So, E);
            if (grouped) { if (fused && IN(pb + 6)) group_barrier(gcnt, 32u, bar.bar); } else SEAM(pb + 5);
        }
    }
    if (IN(N_PHASES - 1)) { RETID(); p_final(F, (const f16*)(F.ws + WS_H), F.fin_g, F.out); }
#undef IN
#undef SEAM
}

extern "C" void kernel_launch(void* const* d_in, const int* in_sizes, int n_in, void* d_out, int out_size, void* d_ws, size_t ws_size, hipStream_t stream) {
    static int grid = 0;
    if (grid == 0) {
        if (n_in != 13 || out_size != S * D || ws_size < WS_END) { fprintf(stderr, "kernel_launch: unexpected shapes (n_in %d out %d ws %zu)\n", n_in, out_size, ws_size); grid = -1; return; }
        int dev = 0, cus = 0, per_cu = 0;
        if (hipGetDevice(&dev) != hipSuccess || hipDeviceGetAttribute(&cus, hipDeviceAttributeMultiprocessorCount, dev) != hipSuccess) { grid = -1; return; }
        if (hipFuncSetAttribute((const void*)mega_fwd, hipFuncAttributeMaxDynamicSharedMemorySize, LDS_BYTES) != hipSuccess) { fprintf(stderr, "kernel_launch: hipFuncSetAttribute failed\n"); grid = -1; return; }
        if (hipOccupancyMaxActiveBlocksPerMultiprocessor(&per_cu, (const void*)mega_fwd, NTHR, LDS_BYTES) != hipSuccess || per_cu < 1) fprintf(stderr, "kernel_launch: occupancy query reports %d\n", per_cu);
        (void)hipGetLastError();
        grid = cus;
    }
    if (grid < 0) return;
    (void)hipMemsetAsync((char*)d_ws + WS_CTL, 0, CTL_ZERO_BYTES, stream);
    Args a{};
    for (int i = 0; i < 13; ++i) a.in[i] = (const float*)d_in[i];
    a.out = (float*)d_out; a.ws = (unsigned char*)d_ws; a.pad = 0;
#if MK_FUSED
    a.ph_lo = 0; a.ph_hi = N_PHASES; a.fused = 1;
    hipLaunchKernelGGL(mega_fwd, dim3(grid), dim3(NTHR), LDS_BYTES, stream, a);
#else
    for (int ph = 0; ph < N_PHASES; ++ph) { a.ph_lo = ph; a.ph_hi = ph + 1; a.fused = 0; hipLaunchKernelGGL(mega_fwd, dim3(grid), dim3(NTHR), LDS_BYTES, stream, a); }
#endif
}
```

```cpp
#include <hip/hip_runtime.h>
#include <cstdio>
#include <cstdint>

#ifndef MK_FUSED
#define MK_FUSED 1
#endif

#define LAS __attribute__((address_space(3)))
#define GAS __attribute__((address_space(1)))
#define DEV __device__ __forceinline__
typedef _Float16 f16;
typedef _Float16 f16x2 __attribute__((ext_vector_type(2)));
typedef _Float16 f16x4 __attribute__((ext_vector_type(4)));
typedef _Float16 f16x8 __attribute__((ext_vector_type(8)));
typedef short s16x4 __attribute__((ext_vector_type(4)));
typedef float f32x2 __attribute__((ext_vector_type(2)));
typedef float f32x4 __attribute__((ext_vector_type(4)));
typedef float f32x16 __attribute__((ext_vector_type(16)));
typedef unsigned u32x2 __attribute__((ext_vector_type(2)));
typedef unsigned u32x4 __attribute__((ext_vector_type(4)));

constexpr int S = 16384, D = 4096, DEPTH = 4, HD = 128;
constexpr int NIN = 13872, NINP = 14080;
constexpr int C_QA = 0, C_KA = 2048, C_VA = 4096, C_ZA = 6144, C_QB = 8192, C_KC = 10240, C_VC = 10496, C_KS = 10752, C_VS = 11008, C_KW = 11264, C_VW = 11520, C_ZB = 11776, C_GT = 13824;
constexpr int DA = 2048, DB = 2048;
constexpr float EPS = 1e-6f;
constexpr float LOG2E = 1.4426950408889634f;
constexpr float QSCALE2 = 0.08838834764831845f * 1.4426950408889634f;
constexpr int NWAVES = 8, NTHR = 512;

constexpr size_t MiB = 1u << 20;
constexpr size_t WS_CTL = 0, CTL_ZERO_BYTES = 1 * MiB;
constexpr size_t WS_WIN = 16 * MiB;
constexpr size_t WS_WOUT = 456 * MiB;
constexpr size_t WS_W1 = 584 * MiB;
constexpr size_t WS_W2 = 600 * MiB;
constexpr size_t WS_CMP = 602 * MiB;
constexpr size_t WS_LSE = 604 * MiB;
constexpr size_t WS_H = 608 * MiB;
constexpr size_t WS_PROJ = 736 * MiB;
constexpr size_t WS_OA = 1176 * MiB;
constexpr size_t WS_OB = 1368 * MiB;
constexpr size_t WS_Y = 1560 * MiB;
constexpr size_t WS_RS = 603 * MiB;
constexpr size_t WS_RSP = 1688 * MiB;
constexpr size_t WS_END = 1692 * MiB;
constexpr int CW_BAR = 4096;
constexpr int CW_CMPD = 32768;
constexpr int CW_GRP = 49152;
constexpr int CW_KMX = 16384;
constexpr float SKIP_LOG2 = -160.0f;

constexpr int RING_BYTES = 155648;
constexpr int MISC_OFF = RING_BYTES;
constexpr int LDS_BYTES = RING_BYTES + 1024;

#define LDS_WAIT() asm volatile("s_waitcnt lgkmcnt(0)" ::: "memory")
#define VM_WAIT() asm volatile("s_waitcnt vmcnt(0)" ::: "memory")

DEV unsigned pk2h(float lo, float hi) { f16x2 v = {(f16)lo, (f16)hi}; return __builtin_bit_cast(unsigned, v); }
DEV float wave_sum(float v) {
#pragma unroll
    for (int o = 1; o < 64; o <<= 1) v += __shfl_xor(v, o);
    return v;
}
DEV float fexp2(float x) { return __builtin_amdgcn_exp2f(x); }

#define XB_TMO      128
#define XB_XCNT(j)  (256  + 64 * (j))
#define XB_XSUB(j)  (1280 + 64 * (j))
#define XB_XGEN(j)  (2304 + 64 * (j))
#define XB_TOP      3328
#define XB_TOPGEN   3392
#define XCD_BAR_WORDS 3456
#define XB_SPIN_CAP (1u << 18)
__device__ __forceinline__ unsigned xb_ld(unsigned* p)              { return __hip_atomic_load(p, __ATOMIC_RELAXED, __HIP_MEMORY_SCOPE_AGENT); }
__device__ __forceinline__ unsigned xb_add(unsigned* p, unsigned v) { return __hip_atomic_fetch_add(p, v, __ATOMIC_RELAXED, __HIP_MEMORY_SCOPE_AGENT); }
__device__ __forceinline__ unsigned xb_xcc_id() { return (unsigned)__builtin_amdgcn_s_getreg((3 << 11) | 20) & 0xFu; }
#define XB_SPIN(cond, bar) do { unsigned _sp = 0; while (cond) { __builtin_amdgcn_s_sleep(1); \
    if ((++_sp & 255u) == 0u) { if (xb_ld(&(bar)[XB_TMO])) break; if (_sp > XB_SPIN_CAP) { atomicAdd(&(bar)[XB_TMO], 1u); break; } } } } while (0)
struct XcdBarrier { unsigned* bar; unsigned x; volatile LAS unsigned* st; };
__device__ __forceinline__ XcdBarrier xcd_barrier_post(unsigned* bar, volatile LAS unsigned* st) {
    XcdBarrier b; b.bar = bar; b.x = xb_xcc_id(); b.st = st;
    if (threadIdx.x == 0) (void)xb_add(&bar[XB_XCNT(b.x)], 1u);
    return b;
}
__device__ __forceinline__ void xcd_barrier_complete(unsigned* bar, unsigned x, unsigned& nloc, unsigned& nx) {
    const unsigned G = gridDim.x * gridDim.y * gridDim.z;
    unsigned sum, cnt, mine, sp = 0u;
    for (;;) {
        sum = 0u; cnt = 0u; mine = 0u;
#pragma unroll
        for (unsigned j = 0; j < 16; ++j) { const unsigned c = xb_ld(&bar[XB_XCNT(j)]); sum += c; cnt += (c > 0u) ? 1u : 0u; mine = (j == x) ? c : mine; }
        if (sum == G) break;
        __builtin_amdgcn_s_sleep(1);
        if ((++sp & 255u) == 0u) { if (xb_ld(&bar[XB_TMO])) break; if (sp > XB_SPIN_CAP) { atomicAdd(&bar[XB_TMO], 1u); break; } }
    }
    nloc = mine > 0u ? mine : 1u; nx = cnt > 0u ? cnt : 1u;
}
__device__ __forceinline__ void xcd_barrier(const XcdBarrier& b) {
    asm volatile("s_waitcnt vmcnt(0)" ::: "memory");
    __syncthreads();
    if (threadIdx.x == 0) {
        unsigned* bar = b.bar;
        __builtin_amdgcn_s_waitcnt(0);
        unsigned nloc = b.st[0], nx = b.st[1];
        if (nloc == 0u) { xcd_barrier_complete(bar, b.x, nloc, nx); b.st[0] = nloc; b.st[1] = nx; }
        const unsigned old = xb_add(&bar[XB_XSUB(b.x)], 1u);
        const unsigned gen = old / nloc;
        if (old + 1u == (gen + 1u) * nloc) {
            __builtin_amdgcn_fence(__ATOMIC_RELEASE, "agent");
            asm volatile("s_waitcnt vmcnt(0)" ::: "memory");
            const unsigned og = xb_add(&bar[XB_TOP], 1u);
            const unsigned tg = og / nx;
            if (og + 1u == (tg + 1u) * nx) xb_add(&bar[XB_TOPGEN], 1u);
            else XB_SPIN(xb_ld(&bar[XB_TOPGEN]) == tg, bar);
            __builtin_amdgcn_fence(__ATOMIC_ACQUIRE, "agent");
            xb_add(&bar[XB_XGEN(b.x)], 1u);
            asm volatile("s_waitcnt vmcnt(0)" ::: "memory");
        } else {
            XB_SPIN(xb_ld(&bar[XB_XGEN(b.x)]) == gen, bar);
            __builtin_amdgcn_fence(__ATOMIC_ACQUIRE, "agent");
            asm volatile("s_waitcnt vmcnt(0)" ::: "memory");
        }
    }
    __syncthreads();
}

__device__ __forceinline__ void group_barrier(unsigned* cnt, unsigned gsz, unsigned* bar) {
    asm volatile("s_waitcnt vmcnt(0)" ::: "memory");
    __syncthreads();
    if (threadIdx.x == 0) {
        __builtin_amdgcn_fence(__ATOMIC_RELEASE, "agent");
        asm volatile("s_waitcnt vmcnt(0)" ::: "memory");
        const unsigned old = xb_add(cnt, 1u);
        const unsigned target = (old / gsz + 1u) * gsz;
        XB_SPIN(xb_ld(cnt) < target, bar);
        __builtin_amdgcn_fence(__ATOMIC_ACQUIRE, "agent");
        asm volatile("s_waitcnt vmcnt(0)" ::: "memory");
    }
    __syncthreads();
}

namespace pg8 {
constexpr int BM = 256, BK = 64, HALF = 128, HTB = HALF * BK * 2, STAGE_BYTES = 8 * HTB, NXCD = 8, WGM = 8;
__host__ __device__ __forceinline__ int lds_byte(int r, int c) { const int st = (r >> 4) * 2 + (c >> 5), rr = r & 15, cc = c & 31, ob = rr * 64 + cc * 2; return st * 1024 + (ob ^ (((ob >> 9) & 1) << 5)); }
__host__ __device__ __forceinline__ void stage_rc(int b, int& R, int& C) { const int st = b / 1024, sb = b % 1024, swz = sb ^ (((sb >> 9) & 1) << 5); R = (st >> 1) * 16 + swz / 64; C = (st & 1) * 32 + (swz % 64) / 2; }
__host__ __device__ __forceinline__ int perm32(int rho) { const int n = rho >> 4, i = rho & 15; return 8 * (i >> 2) + 4 * n + (i & 3); }
struct Unit { int pm, pn; };
struct Gemm { const f16* A; const f16* Bt; int M, N, K; };
struct StaticOrder {
    int nM, nN, nwg, G, c;
    __device__ void init(int M, int N, int G_, int c_) { nM = M / BM; nN = N / BM; nwg = nM * nN; G = G_; c = c_; }
    __device__ bool next(int i, Unit& u) const {
        const long L = (long)i * G + c; if (L >= nwg) return false;
        int wgid = (int)L; { const int q = nwg / NXCD, r = nwg % NXCD, xcd = wgid % NXCD, off = wgid / NXCD; wgid = (xcd < r ? xcd * (q + 1) : r * (q + 1) + (xcd - r) * q) + off; }
        const int nig = WGM * nN, gid = wgid / nig, fm = gid * WGM, gsz = (nM - fm) < WGM ? (nM - fm) : WGM;
        u.pm = fm + ((wgid % nig) % gsz); u.pn = (wgid % nig) / gsz; return true;
    }
    __device__ __forceinline__ void a_ready(const Unit&) const {}
    __device__ __forceinline__ void done(const Unit&) const {}
};
struct EpiF16 {
    static constexpr bool PERM = true, AFTER_DRAIN = false;
    f16* O; int ldc; const float* rs; int* kmx;
    __device__ __forceinline__ void operator()(const f32x4 (&acc)[2][2][4][2], const Unit& u, int wr, int wc, int fr, int fq) const {
        const int row0 = u.pm * BM + wr * 64 + fr; const int col0 = u.pn * BM + wc * 32 + 8 * fq;
        const int kslot = (u.pn >= 8 && u.pn < 16) ? 2 * (u.pn - 8) : (u.pn == 42 ? 16 : (u.pn == 44 ? 18 : -1));
        float rmax[2] = {0.f, 0.f};
#pragma unroll
        for (int ai = 0; ai < 2; ++ai)
#pragma unroll
            for (int m = 0; m < 4; ++m) { const int row = row0 + ai * HALF + m * 16; f16* rowp = O + (size_t)row * ldc + col0; const float sc = rs[row];
#pragma unroll
                for (int bj = 0; bj < 2; ++bj) { const f32x4 v0 = acc[ai][bj][m][0] * sc, v1 = acc[ai][bj][m][1] * sc;
                    u32x4 w; w.x = pk2h(v0[0], v0[1]); w.y = pk2h(v0[2], v0[3]); w.z = pk2h(v1[0], v1[1]); w.w = pk2h(v1[2], v1[3]);
                    *(u32x4*)(rowp + bj * HALF) = w;
                    if (kslot >= 0) { float s8 = ((v0[0] * v0[0] + v0[1] * v0[1]) + (v0[2] * v0[2] + v0[3] * v0[3])) + ((v1[0] * v1[0] + v1[1] * v1[1]) + (v1[2] * v1[2] + v1[3] * v1[3]));
                        s8 += __shfl_xor(s8, 16); s8 += __shfl_xor(s8, 32); rmax[bj] = fmaxf(rmax[bj], s8); } } }
        if (kslot >= 0) {
#pragma unroll
            for (int bj = 0; bj < 2; ++bj) { float v = rmax[bj];
#pragma unroll
                for (int o = 1; o < 16; o <<= 1) v = fmaxf(v, __shfl_xor(v, o));
                if (fr == 0 && fq == 0) atomicMax(kmx + (kslot + bj) * 4 + wc, __float_as_int(v * 1.004f)); }
        }
    }
};
struct EpiRes {
    static constexpr bool PERM = true, AFTER_DRAIN = false;
    f16* X; int ldc; float* ssp;
    __device__ __forceinline__ void operator()(const f32x4 (&acc)[2][2][4][2], const Unit& u, int wr, int wc, int fr, int fq) const {
        const int row0 = u.pm * BM + wr * 64 + fr, col0 = u.pn * BM + wc * 32 + 8 * fq;
#pragma unroll
        for (int ai = 0; ai < 2; ++ai)
#pragma unroll
            for (int m = 0; m < 4; ++m) { const int row = row0 + ai * HALF + m * 16; f16* rowp = X + (size_t)row * ldc + col0; float ss = 0.f;
#pragma unroll
                for (int bj = 0; bj < 2; ++bj) { const f16x8 xo = *(const f16x8*)(rowp + bj * HALF); f32x4 v0 = acc[ai][bj][m][0], v1 = acc[ai][bj][m][1];
                    v0[0] += (float)xo[0]; v0[1] += (float)xo[1]; v0[2] += (float)xo[2]; v0[3] += (float)xo[3]; v1[0] += (float)xo[4]; v1[1] += (float)xo[5]; v1[2] += (float)xo[6]; v1[3] += (float)xo[7];
                    ss += ((v0[0] * v0[0] + v0[1] * v0[1]) + (v0[2] * v0[2] + v0[3] * v0[3])) + ((v1[0] * v1[0] + v1[1] * v1[1]) + (v1[2] * v1[2] + v1[3] * v1[3]));
                    u32x4 w; w.x = pk2h(v0[0], v0[1]); w.y = pk2h(v0[2], v0[3]); w.z = pk2h(v1[0], v1[1]); w.w = pk2h(v1[2], v1[3]);
                    *(u32x4*)(rowp + bj * HALF) = w; }
                if (ssp) { ss += __shfl_xor(ss, 16); ss += __shfl_xor(ss, 32);
                    if (fq == 0) ssp[(size_t)row * 64 + u.pn * 4 + wc] = ss; } }
    }
};

template <class Epi, class Sched, bool ALIGN_EPI = false, bool SP2 = false>
__device__ __forceinline__ void gemm_phase(LAS unsigned char* lds, const Gemm g, const Sched& S, const Epi& E) {
    int tid = threadIdx.x; asm volatile("" : "+v"(tid));
    const int wid = __builtin_amdgcn_readfirstlane(tid >> 6), lane = tid & 63, wr = wid >> 2, wc = wid & 3, fr = lane & 15, fq = lane >> 4;
    const int K = g.K, nt = K / BK;
    unsigned voffA[2], voffB[2];
#pragma unroll
    for (int i = 0; i < 2; ++i) { int R, C; stage_rc(tid * 16 + i * 8192, R, C); const int Rb = Epi::PERM ? ((R & ~31) + perm32(R & 31)) : R;
        voffA[i] = (unsigned)(R * K + C) * 2u; voffB[i] = (unsigned)(Rb * K + C) * 2u; }
    const size_t kstep = (size_t)(BK * 2);
    const size_t hstep = (size_t)HALF * K * 2;
    const size_t tstep = 2 * hstep;
    const unsigned ldsw = (unsigned)wid * 1024u;
    const int aoff = lds_byte(wr * 64 + fr, fq * 8), boff = lds_byte(wc * 32 + fr, fq * 8);
#define PG8_SA(b, h) (((b) * 2 + (h)) * HTB)
#define PG8_SB(b, h) ((4 + (b) * 2 + (h)) * HTB)
#define PG8_STAGE(bufoff, gbase, voff) do { _Pragma("unroll") for (int _i = 0; _i < 2; ++_i) \
        __builtin_amdgcn_global_load_lds((const unsigned*)((const char*)(gbase) + (voff)[_i]), (LAS unsigned*)(lds + (bufoff) + ldsw + _i * 8192), 16, 0, 0); } while (0)
#define PG8_LDA(dst, b, h) do { _Pragma("unroll") for (int m = 0; m < 4; ++m) _Pragma("unroll") for (int k = 0; k < 2; ++k) dst[m][k] = *(const LAS f16x8*)(lds + PG8_SA(b, h) + aoff + m * 2048 + k * 1024); } while (0)
#define PG8_LDB(dst, b, h) do { _Pragma("unroll") for (int n = 0; n < 2; ++n) _Pragma("unroll") for (int k = 0; k < 2; ++k) dst[n][k] = *(const LAS f16x8*)(lds + PG8_SB(b, h) + boff + n * 2048 + k * 1024); } while (0)
#define PG8_MMA(ai, bj, At, Bt) do { __builtin_amdgcn_s_setprio(1); _Pragma("unroll") for (int m = 0; m < 4; ++m) _Pragma("unroll") for (int n = 0; n < 2; ++n) _Pragma("unroll") for (int k = 0; k < 2; ++k) \
        acc[ai][bj][m][n] = __builtin_amdgcn_mfma_f32_16x16x32_f16(Bt[n][k], At[m][k], acc[ai][bj][m][n], 0, 0, 0); __builtin_amdgcn_s_setprio(0); } while (0)
#define PG8_WAIT_V(n) asm volatile("s_waitcnt vmcnt(" #n ")" ::: "memory")
#define PG8_WAIT_L(n) asm volatile("s_waitcnt lgkmcnt(" #n ")" ::: "memory")
#define PG8_BAR __builtin_amdgcn_s_barrier()
#define PG8_SCHED __builtin_amdgcn_sched_barrier(0)
    Unit cur, nxt; int ui = 0;
    if (!S.next(0, cur)) return;
    f32x4 acc[2][2][4][2];
#pragma unroll
    for (int a = 0; a < 2; ++a)
#pragma unroll
        for (int b = 0; b < 2; ++b)
#pragma unroll
            for (int m = 0; m < 4; ++m)
#pragma unroll
                for (int n = 0; n < 2; ++n) acc[a][b][m][n] = (f32x4){0.f, 0.f, 0.f, 0.f};
    f16x8 At[4][2], B0[2][2], B1[2][2];
    const char* cA = (const char*)g.A + (size_t)cur.pm * tstep; const char* cB = (const char*)g.Bt + (size_t)cur.pn * tstep;
    S.a_ready(cur);
    if constexpr (SP2) {
        PG8_STAGE(PG8_SB(0, 0), cB, voffB); PG8_STAGE(PG8_SB(0, 1), cB + hstep, voffB); PG8_STAGE(PG8_SA(0, 0), cA, voffA); PG8_STAGE(PG8_SA(0, 1), cA + hstep, voffA);
        if (wr == 1) PG8_BAR;
        PG8_WAIT_V(2); PG8_BAR;
        PG8_STAGE(PG8_SB(1, 0), cB + kstep, voffB); PG8_STAGE(PG8_SA(1, 0), cA + kstep, voffA); PG8_STAGE(PG8_SB(1, 1), cB + hstep + kstep, voffB);
        PG8_WAIT_V(6); PG8_BAR;
    } else {
        PG8_STAGE(PG8_SB(0, 0), cB, voffB); PG8_STAGE(PG8_SA(0, 0), cA, voffA); PG8_STAGE(PG8_SB(0, 1), cB + hstep, voffB); PG8_STAGE(PG8_SA(0, 1), cA + hstep, voffA);
        if (wr == 1) PG8_BAR;
        PG8_WAIT_V(4); PG8_BAR;
        PG8_STAGE(PG8_SB(1, 0), cB + kstep, voffB); PG8_STAGE(PG8_SA(1, 0), cA + kstep, voffA); PG8_STAGE(PG8_SB(1, 1), cB + hstep + kstep, voffB);
        PG8_WAIT_V(6); PG8_BAR;
    }
    for (;;) {
        const bool has_next = S.next(ui + 1, nxt);
        const char* nA = has_next ? (const char*)g.A + (size_t)nxt.pm * tstep : cA; const char* nB = has_next ? (const char*)g.Bt + (size_t)nxt.pn * tstep : cB;
        for (int t = 0; t < nt; t += 2) {
            const bool last = (t == nt - 2);
            const char* a1 = cA + (size_t)(t + 1) * kstep;
            const char* a2 = last ? nA : cA + (size_t)(t + 2) * kstep; const char* b2 = last ? nB : cB + (size_t)(t + 2) * kstep;
            const char* a3 = a2 + kstep; const char* b3 = b2 + kstep;
            if (last && has_next) S.a_ready(nxt);
            if constexpr (SP2) {
            PG8_LDB(B0, 0, 0); PG8_LDB(B1, 0, 1); PG8_SCHED; PG8_LDA(At, 0, 0); PG8_STAGE(PG8_SA(1, 1), a1 + hstep, voffA);
            PG8_WAIT_V(8); PG8_WAIT_L(0); PG8_BAR; PG8_MMA(0, 0, At, B0); PG8_MMA(0, 1, At, B1); PG8_BAR; PG8_SCHED;
            PG8_LDA(At, 0, 1); PG8_STAGE(PG8_SB(0, 0), b2, voffB); PG8_STAGE(PG8_SB(0, 1), b2 + hstep, voffB); PG8_STAGE(PG8_SA(0, 0), a2, voffA);
            PG8_WAIT_V(8); PG8_WAIT_L(0); PG8_BAR; PG8_MMA(1, 0, At, B0); PG8_MMA(1, 1, At, B1); PG8_BAR; PG8_SCHED;
            PG8_LDB(B0, 1, 0); PG8_LDB(B1, 1, 1); PG8_SCHED; PG8_LDA(At, 1, 0); PG8_STAGE(PG8_SA(0, 1), a2 + hstep, voffA);
            PG8_WAIT_V(8); PG8_WAIT_L(0); PG8_BAR; PG8_MMA(0, 0, At, B0); PG8_MMA(0, 1, At, B1); PG8_BAR; PG8_SCHED;
            PG8_LDA(At, 1, 1); PG8_STAGE(PG8_SB(1, 0), b3, voffB); PG8_STAGE(PG8_SB(1, 1), b3 + hstep, voffB); PG8_STAGE(PG8_SA(1, 0), a3, voffA);
            PG8_WAIT_V(8); PG8_WAIT_L(0); PG8_BAR; PG8_MMA(1, 0, At, B0); PG8_MMA(1, 1, At, B1); PG8_BAR; PG8_SCHED;
            } else {
            PG8_LDB(B0, 0, 0); PG8_SCHED; PG8_LDA(At, 0, 0); PG8_STAGE(PG8_SA(1, 1), a1 + hstep, voffA);
            PG8_WAIT_L(8); PG8_BAR; PG8_WAIT_L(0); PG8_MMA(0, 0, At, B0); PG8_BAR; PG8_SCHED;
            PG8_LDB(B1, 0, 1); PG8_STAGE(PG8_SB(0, 0), b2, voffB);
            PG8_BAR; PG8_WAIT_L(0); PG8_MMA(0, 1, At, B1); PG8_BAR;
            PG8_LDA(At, 0, 1); PG8_STAGE(PG8_SA(0, 0), a2, voffA);
            PG8_BAR; PG8_WAIT_L(0); PG8_MMA(1, 0, At, B0); PG8_BAR; PG8_SCHED;
            PG8_STAGE(PG8_SB(0, 1), b2 + hstep, voffB);
            PG8_WAIT_V(6); PG8_BAR; PG8_MMA(1, 1, At, B1); PG8_BAR;
            PG8_LDB(B0, 1, 0); PG8_SCHED; PG8_LDA(At, 1, 0); PG8_STAGE(PG8_SA(0, 1), a2 + hstep, voffA);
            PG8_WAIT_L(8); PG8_BAR; PG8_WAIT_L(0); PG8_MMA(0, 0, At, B0); PG8_BAR; PG8_SCHED;
            PG8_LDB(B1, 1, 1); PG8_STAGE(PG8_SB(1, 0), b3, voffB);
            PG8_BAR; PG8_WAIT_L(0); PG8_MMA(0, 1, At, B1); PG8_BAR;
            PG8_LDA(At, 1, 1); PG8_STAGE(PG8_SA(1, 0), a3, voffA);
            PG8_BAR; PG8_WAIT_L(0); PG8_MMA(1, 0, At, B0); PG8_BAR; PG8_SCHED;
            PG8_STAGE(PG8_SB(1, 1), b3 + hstep, voffB);
            PG8_WAIT_V(6); PG8_BAR; PG8_MMA(1, 1, At, B1); PG8_BAR;
            }
        }
        if constexpr (ALIGN_EPI) { if (wr == 0) PG8_BAR; }
        if constexpr (!Epi::AFTER_DRAIN) { E(acc, cur, wr, wc, fr, fq); S.done(cur); }
        if (!has_next) break;
#pragma unroll
        for (int a = 0; a < 2; ++a)
#pragma unroll
            for (int b = 0; b < 2; ++b)
#pragma unroll
                for (int m = 0; m < 4; ++m)
#pragma unroll
                    for (int n = 0; n < 2; ++n) acc[a][b][m][n] = (f32x4){0.f, 0.f, 0.f, 0.f};
        cur = nxt; cA = nA; cB = nB; ++ui;
        if constexpr (ALIGN_EPI) { if (wr == 1) PG8_BAR; }
    }
    PG8_WAIT_V(0);
    if constexpr (!ALIGN_EPI) { if (wr == 0) PG8_BAR; }
    PG8_BAR;
#undef PG8_SA
#undef PG8_SB
#undef PG8_STAGE
#undef PG8_LDA
#undef PG8_LDB
#undef PG8_MMA
#undef PG8_WAIT_V
#undef PG8_WAIT_L
#undef PG8_BAR
#undef PG8_SCHED
}
}

struct Frame {
    LAS unsigned char* lds;
    int tid, lane, wave, vcu, G;
    const float *x, *norm_g, *w_in, *k_pe, *k_w1, *k_w2, *v_pe, *v_w1, *v_w2, *og_a, *og_b, *w_out, *fin_g;
    float* out;
    unsigned char* ws;
};

DEV void transpose_item(const float* W, int K, int N, f16* WT, LAS float* scr, int kb, int nb, int lane, const float* gk = nullptr) {
    const int k0 = 64 * kb, n0 = 32 * nb; const int nn = n0 + (lane & 31); const bool inb = nn < N;
    float tv[32];
#pragma unroll
    for (int i = 0; i < 32; ++i) { const int kk = 2 * i + (lane >> 5); tv[i] = inb ? W[(size_t)(k0 + kk) * N + nn] : 0.f; }
    if (gk) {
#pragma unroll
        for (int i = 0; i < 32; ++i) tv[i] *= gk[k0 + 2 * i + (lane >> 5)]; }
#pragma unroll
    for (int i = 0; i < 32; ++i) { const int kk = 2 * i + (lane >> 5); scr[kk * 33 + (lane & 31)] = tv[i]; }
    LDS_WAIT(); asm volatile("" ::: "memory");
    const int c = lane & 7;
#pragma unroll
    for (int j = 0; j < 4; ++j) { const int n = (lane >> 3) + 8 * j; const LAS float* s = scr + (8 * c) * 33 + n;
        u32x4 o; o.x = pk2h(s[0 * 33], s[1 * 33]); o.y = pk2h(s[2 * 33], s[3 * 33]); o.z = pk2h(s[4 * 33], s[5 * 33]); o.w = pk2h(s[6 * 33], s[7 * 33]);
        *(u32x4*)(WT + (size_t)(n0 + n) * K + k0 + 8 * c) = o; }
    LDS_WAIT(); asm volatile("" ::: "memory");
}
DEV void p0_prologue(Frame& F) {
    LAS float* scr = (LAS float*)(F.lds + F.wave * 16384);
    const int gw = F.vcu * NWAVES + F.wave, NGW = F.G * NWAVES;
    constexpr int I_IN = 64 * (NINP / 32), I_W1 = 64 * 8, I_W2 = 4 * 4;
    constexpr int PER_L = I_IN + 2 * I_W1 + 2 * I_W2;
    for (int it = gw; it < DEPTH * PER_L; it += NGW) {
        const int l = it / PER_L; int r = it % PER_L;
        if (r < I_IN) { transpose_item(F.w_in + (size_t)l * D * NIN, D, NIN, (f16*)(F.ws + WS_WIN) + (size_t)l * NINP * D, scr, r / (NINP / 32), r % (NINP / 32), F.lane, F.norm_g + (size_t)l * D); continue; } r -= I_IN;
        if (r < 2 * I_W1) { const int kv = r / I_W1; r %= I_W1; transpose_item((kv ? F.v_w1 : F.k_w1) + (size_t)l * 4096 * 256, 4096, 256, (f16*)(F.ws + WS_W1) + (size_t)(l * 2 + kv) * 256 * 4096, scr, r / 8, r % 8, F.lane); continue; } r -= 2 * I_W1;
        { const int kv = r / I_W2; r %= I_W2; transpose_item((kv ? F.v_w2 : F.k_w2) + (size_t)l * 256 * 128, 256, 128, (f16*)(F.ws + WS_W2) + (size_t)(l * 2 + kv) * 128 * 256, scr, r / 4, r % 4, F.lane); }
    }
}

DEV void backfill_wout(Frame& F, int l) {
    const int nwg = (S / 256) * (NINP / 256), nw = nwg % F.G, c = (int)blockIdx.x;
    if (nw != 0 && c < nw) return;
    const int nid = nw ? F.G - nw : F.G, me = nw ? c - nw : c;
    LAS float* scr = (LAS float*)(F.lds + F.wave * 16384);
    constexpr int I_OUT = 64 * (D / 32);
    for (int r = me * NWAVES + F.wave; r < I_OUT; r += nid * NWAVES)
        transpose_item(F.w_out + (size_t)l * D * D, D, D, (f16*)(F.ws + WS_WOUT) + (size_t)l * D * D, scr, r / (D / 32), r % (D / 32), F.lane);
}

DEV void p1_rownorm(Frame& F, const float* xin, f16* h, float* rs) {
    const int gw = F.vcu * NWAVES + F.wave, NGW = F.G * NWAVES;
    for (int row = gw; row < S; row += NGW) {
        const f32x4* xr = (const f32x4*)(xin + (size_t)row * D) + F.lane;
        f32x4 v[16]; float ss = 0.f;
#pragma unroll
        for (int j = 0; j < 16; ++j) { v[j] = xr[64 * j]; ss += (v[j].x * v[j].x + v[j].y * v[j].y) + (v[j].z * v[j].z + v[j].w * v[j].w); }
        ss = wave_sum(ss);
        if (F.lane == 0) rs[row] = 1.0f / sqrtf(ss * (1.0f / D) + EPS);
        u32x2* o = (u32x2*)(h + (size_t)row * D) + F.lane;
#pragma unroll
        for (int j = 0; j < 16; ++j) { u32x2 w; w.x = pk2h(v[j].x, v[j].y); w.y = pk2h(v[j].z, v[j].w); o[64 * j] = w; }
    }
}
DEV void p1_rowscale(Frame& F, const float* ssp, float* rs) {
    for (int row = F.vcu * NTHR + F.tid; row < S; row += F.G * NTHR) {
        const f32x4* p = (const f32x4*)(ssp + (size_t)row * 64); float ss = 0.f;
#pragma unroll
        for (int j = 0; j < 16; ++j) { const f32x4 v = p[j]; ss += (v.x + v.y) + (v.z + v.w); }
        rs[row] = 1.0f / sqrtf(ss * (1.0f / D) + EPS);
    }
}
DEV void rowscale_tile(Frame& F, const float* ssp, float* rs, int pm) {
    if (F.tid < 256) { const int row = pm * 256 + F.tid;
        const f32x4* p = (const f32x4*)(ssp + (size_t)row * 64); float ss = 0.f;
#pragma unroll
        for (int j = 0; j < 16; ++j) { const f32x4 v = p[j]; ss += (v.x + v.y) + (v.z + v.w); }
        rs[row] = 1.0f / sqrtf(ss * (1.0f / D) + EPS); }
    asm volatile("s_waitcnt vmcnt(0)" ::: "memory");
    __syncthreads();
}
DEV void p_final(Frame& F, const f16* xin, const float* g, float* out) {
    const bool grp = F.G == 256;
    const int xg = F.vcu >> 5, gw = grp ? 2048 * xg + NWAVES * (F.vcu & 31) + F.wave : F.vcu * NWAVES + F.wave, NGW = F.G * NWAVES;
    const int nj = grp ? 8 : (gw < S ? (S - gw + NGW - 1) / NGW : 0);
    for (int j = 0; j < nj; ++j) { const int row = grp ? gw + 256 * ((j + xg) & 7) : gw + NGW * j;
        const f16x8* xr = (const f16x8*)(xin + (size_t)row * D) + F.lane;
        f16x8 v[8]; float ss = 0.f;
#pragma unroll
        for (int j = 0; j < 8; ++j) { v[j] = xr[64 * j];
#pragma unroll
            for (int e = 0; e < 8; ++e) ss += (float)v[j][e] * (float)v[j][e]; }
        ss = wave_sum(ss);
        const float rs = 1.0f / sqrtf(ss * (1.0f / D) + EPS);
#pragma unroll
        for (int j = 0; j < 8; ++j) { const int c0 = 8 * (F.lane + 64 * j); const f32x4 g0 = *(const f32x4*)(g + c0), g1 = *(const f32x4*)(g + c0 + 4);
            f32x4 o0, o1; o0.x = (float)v[j][0] * rs * g0.x; o0.y = (float)v[j][1] * rs * g0.y; o0.z = (float)v[j][2] * rs * g0.z; o0.w = (float)v[j][3] * rs * g0.w;
            o1.x = (float)v[j][4] * rs * g1.x; o1.y = (float)v[j][5] * rs * g1.y; o1.z = (float)v[j][6] * rs * g1.z; o1.w = (float)v[j][7] * rs * g1.w;
            *(f32x4*)(out + (size_t)row * D + c0) = o0; *(f32x4*)(out + (size_t)row * D + c0 + 4) = o1; }
    }
}

DEV unsigned offa(unsigned row, unsigned ch) { return 2048u * (row >> 3) + 512u * (ch >> 2) + 64u * (row & 7u) + 16u * ((ch & 3u) ^ ((row >> 2) & 3u)); }
struct Geo { unsigned kb0, kb1, vb0, vb1; };
DEV Geo make_geo(int lane) {
    Geo g; const unsigned r = lane & 31, hh = lane >> 5, Y = (r >> 2) & 3u;
    const unsigned kb = 2048u * (r >> 3) + 64u * (r & 7u);
    g.kb0 = kb + 16u * (2u * (Y >> 1) + (hh ^ (Y & 1u)));
    g.kb1 = kb + 16u * (2u * (1u ^ (Y >> 1)) + (hh ^ (Y & 1u)));
    const unsigned blk = (lane >> 4) & 1, q = (lane & 15) >> 2, p = lane & 3;
    const unsigned vb = 64u * (4u * hh + q) + 8u * (p & 1u) + 16u * ((p >> 1) ^ hh);
    g.vb0 = vb + 32u * blk;
    g.vb1 = vb + 32u * (blk ^ 1u) + 2048u;
    return g;
}
struct Att { f32x16 acc[4]; float m, l; };
DEV void att_init(Att& a) {
#pragma unroll
    for (int c = 0; c < 4; ++c)
#pragma unroll
        for (int i = 0; i < 16; ++i) a.acc[c][i] = 0.f;
    a.m = -1e30f; a.l = 0.f;
}
DEV float half_max(float v) { auto rr = __builtin_amdgcn_permlane32_swap(__float_as_uint(v), __float_as_uint(v), false, false); return fmaxf(__uint_as_float(rr[0]), __uint_as_float(rr[1])); }
DEV float half_sum(float v) { auto rr = __builtin_amdgcn_permlane32_swap(__float_as_uint(v), __float_as_uint(v), false, false); return __uint_as_float(rr[0]) + __uint_as_float(rr[1]); }

struct KFr { f16x8 k[8]; };
struct VFr { s16x4 r[2][4][2]; };
DEV void k_issue(KFr& f, LAS const unsigned char* kt, const Geo& g) {
    const unsigned a0 = (unsigned)(size_t)(kt + g.kb0), a1 = (unsigned)(size_t)(kt + g.kb1);
    asm volatile(
        "ds_read_b128 %0, %8\n\tds_read_b128 %1, %9\n\tds_read_b128 %2, %8 offset:512\n\tds_read_b128 %3, %9 offset:512\n\t"
        "ds_read_b128 %4, %8 offset:1024\n\tds_read_b128 %5, %9 offset:1024\n\tds_read_b128 %6, %8 offset:1536\n\tds_read_b128 %7, %9 offset:1536"
        : "=&v"(f.k[0]), "=&v"(f.k[1]), "=&v"(f.k[2]), "=&v"(f.k[3]), "=&v"(f.k[4]), "=&v"(f.k[5]), "=&v"(f.k[6]), "=&v"(f.k[7])
        : "v"(a0), "v"(a1) : "memory");
}
DEV void k_wait(KFr& f) {
    asm volatile("s_waitcnt lgkmcnt(0)" : "+v"(f.k[0]), "+v"(f.k[1]), "+v"(f.k[2]), "+v"(f.k[3]), "+v"(f.k[4]), "+v"(f.k[5]), "+v"(f.k[6]), "+v"(f.k[7]));
}
DEV void v_issue(VFr& f, LAS const unsigned char* vt, const Geo& g) {
    const unsigned a0 = (unsigned)(size_t)(vt + g.vb0), a1 = (unsigned)(size_t)(vt + g.vb1);
    asm volatile(
        "ds_read_b64_tr_b16 %0, %16\n\tds_read_b64_tr_b16 %1, %17\n\t"
        "ds_read_b64_tr_b16 %2, %16 offset:512\n\tds_read_b64_tr_b16 %3, %17 offset:512\n\t"
        "ds_read_b64_tr_b16 %4, %16 offset:1024\n\tds_read_b64_tr_b16 %5, %17 offset:1024\n\t"
        "ds_read_b64_tr_b16 %6, %16 offset:1536\n\tds_read_b64_tr_b16 %7, %17 offset:1536\n\t"
        "ds_read_b64_tr_b16 %8, %16 offset:4096\n\tds_read_b64_tr_b16 %9, %17 offset:4096\n\t"
        "ds_read_b64_tr_b16 %10, %16 offset:4608\n\tds_read_b64_tr_b16 %11, %17 offset:4608\n\t"
        "ds_read_b64_tr_b16 %12, %16 offset:5120\n\tds_read_b64_tr_b16 %13, %17 offset:5120\n\t"
        "ds_read_b64_tr_b16 %14, %16 offset:5632\n\tds_read_b64_tr_b16 %15, %17 offset:5632"
        : "=&v"(f.r[0][0][0]), "=&v"(f.r[0][0][1]), "=&v"(f.r[0][1][0]), "=&v"(f.r[0][1][1]), "=&v"(f.r[0][2][0]), "=&v"(f.r[0][2][1]), "=&v"(f.r[0][3][0]), "=&v"(f.r[0][3][1]),
          "=&v"(f.r[1][0][0]), "=&v"(f.r[1][0][1]), "=&v"(f.r[1][1][0]), "=&v"(f.r[1][1][1]), "=&v"(f.r[1][2][0]), "=&v"(f.r[1][2][1]), "=&v"(f.r[1][3][0]), "=&v"(f.r[1][3][1])
        : "v"(a0), "v"(a1) : "memory");
}
DEV void v_wait(VFr& f) {
    asm volatile("s_waitcnt lgkmcnt(0)"
        : "+v"(f.r[0][0][0]), "+v"(f.r[0][0][1]), "+v"(f.r[0][1][0]), "+v"(f.r[0][1][1]), "+v"(f.r[0][2][0]), "+v"(f.r[0][2][1]), "+v"(f.r[0][3][0]), "+v"(f.r[0][3][1]),
          "+v"(f.r[1][0][0]), "+v"(f.r[1][0][1]), "+v"(f.r[1][1][0]), "+v"(f.r[1][1][1]), "+v"(f.r[1][2][0]), "+v"(f.r[1][2][1]), "+v"(f.r[1][3][0]), "+v"(f.r[1][3][1]));
}
template <int KS>
DEV f32x16 qk_raw(const KFr& kf, const f16x8 (&qf)[8], const f32x16& sc, int D0p, int hh, unsigned dmax) {
    f32x16 x = __builtin_amdgcn_mfma_f32_32x32x16_f16(kf.k[0], qf[0], sc, 0, 0, 0);
#pragma unroll
    for (int s = 1; s < 8; ++s) x = __builtin_amdgcn_mfma_f32_32x32x16_f16(kf.k[s], qf[s], x, 0, 0, 0);
    const int D0 = D0p + 4 * KS * hh;
    const bool full = __all((D0 - 31 * KS >= 0) && (D0 <= (int)dmax));
    if (!full) {
        const float NEG = -__builtin_inff();
#pragma unroll
        for (int i = 0; i < 16; ++i) { const int ci = (i & 3) + 8 * (i >> 2); const int dist = D0p - KS * ci; x[i] = ((unsigned)dist <= dmax) ? x[i] : NEG; }
    }
    return x;
}
template <int KS> DEV f32x16 make_sc(float sl) { f32x16 sc;
#pragma unroll
    for (int i = 0; i < 16; ++i) sc[i] = sl * (float)(KS * ((i & 3) + 8 * (i >> 2)));
    return sc; }
DEV void pv_mma(Att& st, const VFr& vf, const f32x16& p) {
    u32x4 pw[2];
#pragma unroll
    for (int s = 0; s < 2; ++s)
#pragma unroll
        for (int j = 0; j < 4; ++j) pw[s][j] = __builtin_bit_cast(unsigned, __builtin_amdgcn_cvt_pkrtz(p[8 * s + 2 * j], p[8 * s + 2 * j + 1]));
#pragma unroll
    for (int ks = 0; ks < 2; ++ks)
#pragma unroll
        for (int c = 0; c < 4; ++c) {
            const f16x8 vv = __builtin_shufflevector(__builtin_bit_cast(f16x4, vf.r[ks][c][0]), __builtin_bit_cast(f16x4, vf.r[ks][c][1]), 0, 1, 2, 3, 4, 5, 6, 7);
            st.acc[c] = __builtin_amdgcn_mfma_f32_32x32x16_f16(vv, __builtin_bit_cast(f16x8, pw[ks]), st.acc[c], 0, 0, 0);
        }
}
DEV void att_online(Att& st, LAS const unsigned char* vt, const Geo& g, f32x16 x, float base) {
    float tmax = fmaxf(fmaxf(x[0], x[1]), x[2]);
#pragma unroll
    for (int i = 3; i < 15; i += 2) tmax = fmaxf(fmaxf(tmax, x[i]), x[i + 1]);
    tmax = fmaxf(tmax, x[15]);
    tmax = half_max(tmax + base);
    const float mn = fmaxf(st.m, tmax);
    const float alpha = fexp2(st.m - mn);
    st.m = mn;
    const float nb = base - mn;
    float ps0 = 0.f, ps1 = 0.f;
#pragma unroll
    for (int i = 0; i < 16; i += 2) { x[i] = fexp2(x[i] + nb); x[i + 1] = fexp2(x[i + 1] + nb); ps0 += x[i]; ps1 += x[i + 1]; }
    st.l = st.l * alpha + (ps0 + ps1);
    u32x4 pw[2];
#pragma unroll
    for (int s = 0; s < 2; ++s)
#pragma unroll
        for (int j = 0; j < 4; ++j) pw[s][j] = __builtin_bit_cast(unsigned, __builtin_amdgcn_cvt_pkrtz(x[8 * s + 2 * j], x[8 * s + 2 * j + 1]));
    VFr vf; v_issue(vf, vt, g);
    if (!__all(alpha == 1.0f)) {
#pragma unroll
        for (int c = 0; c < 4; ++c)
#pragma unroll
            for (int i = 0; i < 16; ++i) st.acc[c][i] *= alpha;
    }
    v_wait(vf);
#pragma unroll
    for (int ks = 0; ks < 2; ++ks)
#pragma unroll
        for (int c = 0; c < 4; ++c) {
            const f16x8 vv = __builtin_shufflevector(__builtin_bit_cast(f16x4, vf.r[ks][c][0]), __builtin_bit_cast(f16x4, vf.r[ks][c][1]), 0, 1, 2, 3, 4, 5, 6, 7);
            st.acc[c] = __builtin_amdgcn_mfma_f32_32x32x16_f16(vv, __builtin_bit_cast(f16x8, pw[ks]), st.acc[c], 0, 0, 0);
        }
}
DEV void att_stats(float& m, float& l, const f32x16& x, float base) {
    float tmax = fmaxf(fmaxf(x[0], x[1]), x[2]);
#pragma unroll
    for (int i = 3; i < 15; i += 2) tmax = fmaxf(fmaxf(tmax, x[i]), x[i + 1]);
    tmax = fmaxf(tmax, x[15]);
    tmax = half_max(tmax + base);
    const float mn = fmaxf(m, tmax);
    const float alpha = fexp2(m - mn);
    m = mn;
    const float nb = base - mn;
    float ps0 = 0.f, ps1 = 0.f;
#pragma unroll
    for (int i = 0; i < 16; i += 2) { ps0 += fexp2(x[i] + nb); ps1 += fexp2(x[i + 1] + nb); }
    l = l * alpha + (ps0 + ps1);
}
DEV void load_q(f16x8 (&qf)[8], const f16* qrow  ) {
#pragma unroll
    for (int s = 0; s < 8; ++s) qf[s] = *(const f16x8*)(qrow + 16 * s) * (f16)QSCALE2;
}


DEV float kmax_of(const int* kmx, int slot) { const int* p = kmx + slot * 4; return sqrtf(__int_as_float(p[0]) + __int_as_float(p[1]) + __int_as_float(p[2]) + __int_as_float(p[3])); }
DEV float q_norm(const f16x8 (&qf)[8]) { float s = 0.f;
#pragma unroll
    for (int i = 0; i < 8; ++i)
#pragma unroll
        for (int j = 0; j < 8; ++j) { const float v = (float)qf[i][j]; s += v * v; }
    return sqrtf(half_sum(s)) * 1.001f; }
DEV void slot_rc(int pc, int L, int& row, int& ch) { const int a = pc >> 1, b = (L >> 2) & 7; row = 8 * a + b; const int x = (2 * a + (b >> 2)) & 3; ch = 4 * (2 * (pc & 1) + (L >> 5)) + ((L & 3) ^ x); }
DEV void dma16(const void* g, LAS unsigned char* l) { __builtin_amdgcn_global_load_lds((const unsigned*)g, (LAS unsigned*)l, 16, 0, 0); }
#define WAITV_BAR(n) do { asm volatile("s_waitcnt vmcnt(" #n ") lgkmcnt(0)" ::: "memory"); __builtin_amdgcn_s_barrier(); asm volatile("" ::: "memory"); } while (0)

DEV float gelu_tanh(float v) { const float u = 0.7978845608028654f * (v + 0.044715f * v * v * v); const float e = fexp2(-2.0f * LOG2E * u); return v / (1.0f + e); }
DEV void cmp_unit(Frame& F, int cu, int layer) {
    const int kv = cu & 1, g = (cu >> 1) & 1, ct = cu >> 2;
    const int lane = F.lane, w = F.wave, r = lane & 31, hh = lane >> 5;
    const f16* proj = (const f16*)(F.ws + WS_PROJ);
    const float* pe = (kv ? F.v_pe : F.k_pe) + (size_t)layer * 32 * 128;
    const f16* W1t = (const f16*)(F.ws + WS_W1) + (size_t)(layer * 2 + kv) * 256 * 4096;
    const f16* W2t = (const f16*)(F.ws + WS_W2) + (size_t)(layer * 2 + kv) * 128 * 256;
    LAS float* accb = (LAS float*)F.lds;
    LAS f16* hid = (LAS f16*)(F.lds + 32768);
    const int c = 32 * ct + r; const int colbase = (kv ? C_VC : C_KC) + g * 128;
    f32x16 acc[8];
#pragma unroll
    for (int n = 0; n < 8; ++n)
#pragma unroll
        for (int i = 0; i < 16; ++i) acc[n][i] = 0.f;
#pragma unroll 2
    for (int s = 0; s < 32; ++s) {
        const int l = 4 * w + (s >> 3), dd = 16 * (s & 7) + 8 * hh;
        int tok = 16 * c + l; tok = tok < S ? tok : S - 1;
        const f16x8 xv = *(const f16x8*)(proj + (size_t)tok * NINP + colbase + dd);
        const f32x4 p0 = *(const f32x4*)(pe + l * 128 + dd), p1 = *(const f32x4*)(pe + l * 128 + dd + 4);
        f16x8 af;
        af[0] = (f16)((float)xv[0] + p0.x); af[1] = (f16)((float)xv[1] + p0.y); af[2] = (f16)((float)xv[2] + p0.z); af[3] = (f16)((float)xv[3] + p0.w);
        af[4] = (f16)((float)xv[4] + p1.x); af[5] = (f16)((float)xv[5] + p1.y); af[6] = (f16)((float)xv[6] + p1.z); af[7] = (f16)((float)xv[7] + p1.w);
        const int kk = l * 128 + dd;
#pragma unroll
        for (int n = 0; n < 8; ++n) { const f16x8 bf = *(const f16x8*)(W1t + (size_t)(32 * n + r) * 4096 + kk); acc[n] = __builtin_amdgcn_mfma_f32_32x32x16_f16(af, bf, acc[n], 0, 0, 0); }
    }
    for (int ww = 0; ww < 8; ++ww) {
        if (w == ww) {
#pragma unroll
            for (int n = 0; n < 8; ++n)
#pragma unroll
                for (int i = 0; i < 16; ++i) { const int cr = (i & 3) + 8 * (i >> 2) + 4 * hh; LAS float* p = accb + cr * 256 + 32 * n + r; *p = (ww == 0) ? acc[n][i] : (*p + acc[n][i]); }
        }
        __syncthreads();
    }
    for (int e = F.tid; e < 32 * 256; e += NTHR) { const int cr = e >> 8, n = e & 255; hid[cr * 264 + n] = (f16)gelu_tanh(accb[e]); }
    __syncthreads();
    if (w < 4) {
        f32x16 o;
#pragma unroll
        for (int i = 0; i < 16; ++i) o[i] = 0.f;
#pragma unroll
        for (int s = 0; s < 16; ++s) { const f16x8 af = *(const LAS f16x8*)(hid + r * 264 + 16 * s + 8 * hh); const f16x8 bf = *(const f16x8*)(W2t + (size_t)(32 * w + r) * 256 + 16 * s + 8 * hh);
            o = __builtin_amdgcn_mfma_f32_32x32x16_f16(af, bf, o, 0, 0, 0); }
        f16* outp = (f16*)(F.ws + WS_CMP) + (size_t)((kv * 2 + g) * 1024) * 128;
#pragma unroll
        for (int i = 0; i < 16; ++i) { const int cr = (i & 3) + 8 * (i >> 2) + 4 * hh; const int cc = 32 * ct + cr; outp[(size_t)cc * 128 + 32 * w + r] = (cc < 1023) ? (f16)o[i] : (f16)0.f; }
        if (kv == 0) {
            float pm = 0.f;
#pragma unroll
            for (int i = 0; i < 16; ++i) { float sq = o[i] * o[i];
#pragma unroll
                for (int sh = 1; sh < 32; sh <<= 1) sq += __shfl_xor(sq, sh);
                pm = fmaxf(pm, sq); }
            pm = fmaxf(pm, __shfl_xor(pm, 32));
            if (lane == 0) atomicMax((int*)(F.ws + WS_CTL) + CW_KMX + layer * 96 + (20 + g) * 4 + w, __float_as_int(pm * 1.004f));
        }
    }
    asm volatile("s_waitcnt vmcnt(0)" ::: "memory");
    __syncthreads();
    if (F.tid == 0) { __builtin_amdgcn_fence(__ATOMIC_RELEASE, "agent"); asm volatile("s_waitcnt vmcnt(0)" ::: "memory"); (void)xb_add((unsigned*)(F.ws + WS_CTL) + CW_CMPD + 64 * layer, 1u); }
}

DEV const f16* a_unit_qrow(Frame& F, int u) {
    const int hp = u / 384, rem = u % 384, p = rem >> 7, nb = rem & 127;
    const int dsh = 2 * p, dil = 1 << dsh, nbr = 128 >> dsh, rr = nb / nbr, n = nb % nbr;
    const int half = F.wave >> 2, wq = (F.wave & 4) ? 3 - (F.wave & 3) : (F.wave & 3), ql = F.lane & 31, hh = F.lane >> 5;
    const int qsub = 128 * n + 32 * wq + ql, tq = qsub * dil + rr;
    return (const f16*)(F.ws + WS_PROJ) + (size_t)tq * NINP + C_QA + (2 * hp + half) * 128 + 8 * hh;
}
DEV void attn_a_unit(Frame& F, int u, f16x8 (&qf)[8], int un, int layer) {
    const int hp = u / 384, rem = u % 384, p = rem >> 7, nb = rem & 127;
    const int dsh = 2 * p, dil = 1 << dsh, nbr = 128 >> dsh;
    const int rr = nb / nbr, n = nb % nbr;
    const int lane = F.lane, half = F.wave >> 2, wq = (F.wave & 4) ? 3 - (F.wave & 3) : (F.wave & 3), ql = lane & 31, hh = lane >> 5;
    const int head = 2 * hp + half;
    const f16* proj = (const f16*)(F.ws + WS_PROJ);
    const int qsub = 128 * n + 32 * wq + ql, tq = qsub * dil + rr;
    const float sl = fexp2(-0.5f * (float)(head + 1)) * (float)dil * LOG2E;
    const unsigned dmax = (unsigned)(qsub < 128 ? qsub : 128);
    const Geo g = make_geo(lane);
    const f32x16 sc = make_sc<1>(sl);
    const float bq = q_norm(qf) * kmax_of((const int*)(F.ws + WS_CTL) + CW_KMX + layer * 96, head) + sl * 31.0f;
    Att st; att_init(st);
    LAS unsigned char* base = F.lds + half * 65536;
    int r0, c0, r1, c1; slot_rc(2 * wq, lane, r0, c0); slot_rc(2 * wq + 1, lane, r1, c1);
    const int ksub0 = 128 * (n - 1);
    const f16* colb = proj + head * 128;
#define A_ISSUE(I) do { const int Jc = (I) < 4 ? 3 - (I) : 0; LAS unsigned char* sb_ = base + ((I) & 1) * 32768 + wq * 2048; \
        _Pragma("unroll") for (int sub_ = 0; sub_ < 2; ++sub_) { \
        int s0 = ksub0 + 64 * Jc + 32 * sub_ + r0, s1 = ksub0 + 64 * Jc + 32 * sub_ + r1; s0 = s0 < 0 ? 0 : s0; s1 = s1 < 0 ? 0 : s1; \
        const f16* g0 = colb + (size_t)(s0 * dil + rr) * NINP + c0 * 8; const f16* g1 = colb + (size_t)(s1 * dil + rr) * NINP + c1 * 8; \
        dma16(g0 + C_KA, sb_ + sub_ * 16384); dma16(g1 + C_KA, sb_ + sub_ * 16384 + 1024); dma16(g0 + C_VA, sb_ + sub_ * 16384 + 8192); dma16(g1 + C_VA, sb_ + sub_ * 16384 + 8192 + 1024); } } while (0)
    A_ISSUE(0);
#pragma nounroll
    for (int i = 0; i < 4; ++i) {
        WAITV_BAR(0);
        if (i < 3) A_ISSUE(i + 1);
#pragma unroll
        for (int sub = 1; sub >= 0; --sub) {
            const int T = 2 * (3 - i) + sub;
            const int D0p = 128 + 32 * (wq - T) + ql - 4 * hh;
            if (T >= wq && T <= wq + 4 && !__all(bq - sl * (float)D0p - st.m < SKIP_LOG2)) {
                LAS unsigned char* sb = base + (i & 1) * 32768 + sub * 16384;
                KFr kf; k_issue(kf, sb, g); k_wait(kf);
                const f32x16 x = qk_raw<1>(kf, qf, sc, D0p, hh, dmax);
                att_online(st, sb + 8192, g, x, -sl * (float)D0p);
            }
        }
    }
#undef A_ISSUE
    if (un >= 0) load_q(qf, a_unit_qrow(F, un));
    const float lt = half_sum(st.l);
    const float inv = 1.0f / lt;
    LAS unsigned char* ost = base + wq * 8192;
#pragma unroll
    for (int c = 0; c < 4; ++c)
#pragma unroll
        for (int gq = 0; gq < 4; ++gq) { u32x2 w; w.x = pk2h(st.acc[c][4 * gq] * inv, st.acc[c][4 * gq + 1] * inv); w.y = pk2h(st.acc[c][4 * gq + 2] * inv, st.acc[c][4 * gq + 3] * inv);
            *(LAS u32x2*)(ost + ql * 256 + (((4 * c + gq) ^ (ql & 15)) << 4) + 8 * hh) = w; }
    asm volatile("s_waitcnt lgkmcnt(0)" ::: "memory");
    {
        const int ch = lane & 15;
        f16* oab = (f16*)(F.ws + WS_OA) + (size_t)p * S * DA + head * 128 + ch * 8;
#pragma unroll
        for (int j = 0; j < 8; ++j) { const int row = 4 * j + (lane >> 4);
            const u32x4 v = *(LAS const u32x4*)(ost + row * 256 + ((ch ^ (row & 15)) << 4));
            *(u32x4*)(oab + (size_t)((128 * n + 32 * wq + row) * dil + rr) * DA) = v; }
    }
    if (hh == 0) ((float*)(F.ws + WS_LSE))[((size_t)p * S + tq) * 16 + head] = st.m + __builtin_amdgcn_logf(lt);
    asm volatile("s_waitcnt lgkmcnt(0)" ::: "memory"); __builtin_amdgcn_s_barrier(); asm volatile("" ::: "memory");
}

constexpr int NSA_NS = 5;
DEV void nsa_unit(Frame& F, int chunk, int gq, int layer) {
    const int lane = F.lane, w = F.wave, ql = lane & 31, hh = lane >> 5, tid = F.tid;
    const int hw = w < 4 ? w : 11 - w;
    const int t0 = 32 * chunk, t = t0 + ql, head = 8 * gq + hw, cur = t0 >> 6;
    const f16* proj = (const f16*)(F.ws + WS_PROJ);
    f16x8 qf[8]; load_q(qf, proj + (size_t)t * NINP + C_QB + head * 128 + 8 * hh);
    const float sl = fexp2(-0.5f * (float)(head + 1)) * LOG2E;
    const Geo g = make_geo(lane);
    LAS unsigned char* tiles = F.lds;
    LAS float* imp = (LAS float*)(F.lds + 81920);
    LAS float* part = (LAS float*)(F.lds + 114688);
    LAS float* carry = (LAS float*)(F.lds + 147456);
    LAS unsigned* sel = (LAS unsigned*)(F.lds + 147456 + 256);
    LAS unsigned* uni = sel + 256;
    LAS unsigned* blist = sel + 272;
    int lr, lch; slot_rc(w, lane, lr, lch);
    LAS unsigned char* mypiece = tiles + w * 1024;
    f16* ob = (f16*)(F.ws + WS_OB) + (size_t)t * DB + head * 128;
#define NSA_STORE(br, scale) do { f16* _o = ob + (size_t)(br) * S * DB; const float _s = (scale); \
        _Pragma("unroll") for (int c = 0; c < 4; ++c) _Pragma("unroll") for (int gg = 0; gg < 4; ++gg) { u32x2 wv; wv.x = pk2h(st.acc[c][4 * gg] * _s, st.acc[c][4 * gg + 1] * _s); wv.y = pk2h(st.acc[c][4 * gg + 2] * _s, st.acc[c][4 * gg + 3] * _s); \
            *(u32x2*)(_o + 32 * c + 8 * gg + 4 * hh) = wv; } } while (0)

    const f16* kwb = proj + C_KW + gq * 128 + (size_t)lr * NINP + lch * 8; const f16* vwb = proj + C_VW + gq * 128 + (size_t)lr * NINP + lch * 8;
    const int Tl = (t0 >> 5); const int Tf = Tl >= 16 ? Tl - 16 : 0; const int nw = Tl - Tf + 1;
#define W_ISSUE(I) do { LAS unsigned char* sb_ = mypiece + ((I) & 1) * 32768; \
        _Pragma("unroll") for (int sub_ = 0; sub_ < 2; ++sub_) { int tt_ = Tl - 2 * (I) - (1 - sub_); tt_ = tt_ < Tf ? Tf : tt_; const size_t ro = (size_t)(32 * tt_) * NINP; \
            dma16(kwb + ro, sb_ + sub_ * 16384); dma16(vwb + ro, sb_ + sub_ * 16384 + 8192); } } while (0)
    const f16* kc = (const f16*)(F.ws + WS_CMP) + (size_t)((0 * 2 + gq) * 1024) * 128 + (size_t)lr * 128 + lch * 8;
    const f16* vc = (const f16*)(F.ws + WS_CMP) + (size_t)((1 * 2 + gq) * 1024) * 128 + (size_t)lr * 128 + lch * 8;
    const int ntc = (t0 >> 9) + 1;
    const f32x16 sc16 = make_sc<16>(sl);
    const float qn = q_norm(qf); const int* kmx = (const int*)(F.ws + WS_CTL) + CW_KMX + layer * 96;
    const float bqC = qn * kmax_of(kmx, 20 + gq) + sl * 16.0f * 31.0f;
    float m_c = -1e30f, l_c = 0.f;
#define C1_ISSUE(I) do { const int Tc = (I) < ntc ? ntc - 1 - (I) : 0; dma16(kc + (size_t)Tc * 4096, mypiece + ((I) % NSA_NS) * 16384); } while (0)
    C1_ISSUE(0); C1_ISSUE(1); C1_ISSUE(2); C1_ISSUE(3);
#pragma nounroll
    for (int I = 0; I < ntc; ++I) {
        WAITV_BAR(3);
        const int T = ntc - 1 - I;
        const int D0p = t - 31 - 512 * T - 64 * hh;
        const bool skip = __all(bqC - sl * (float)D0p - m_c < SKIP_LOG2);
        C1_ISSUE(I + 4);
        if (!skip) {
            KFr kf; k_issue(kf, tiles + (I % NSA_NS) * 16384, g); k_wait(kf);
            const f32x16 x = qk_raw<16>(kf, qf, sc16, D0p, hh, 1u << 30);
            att_stats(m_c, l_c, x, -sl * (float)D0p);
        }
    }
#undef C1_ISSUE
    l_c = half_sum(l_c);
    const float invl_c = l_c > 0.f ? 1.0f / l_c : 0.f;
    WAITV_BAR(0);
    {
        Att st; att_init(st);
#define C2_ISSUE(T) do { const int Tc = (T) < ntc ? (T) : ntc - 1; LAS unsigned char* sb_ = mypiece + ((T) % NSA_NS) * 16384; dma16(kc + (size_t)Tc * 4096, sb_); dma16(vc + (size_t)Tc * 4096, sb_ + 8192); } while (0)
#define C2_REDUCE(tau) do { const LAS float* pp = part + ((tau) & 1) * 4096; const int q = tid >> 4, k = (tid >> 1) & 7, wh = tid & 1; float sred = 0.f; \
        _Pragma("unroll") for (int ww = 0; ww < 8; ++ww) sred += pp[((ww * 32 + q) * 8 + k) * 2 + wh]; \
        const float up = __shfl_up(sred, 1); \
        if (wh == 0) { const float add = k >= 1 ? up : ((tau) >= 1 ? carry[(((tau) - 1) & 1) * 32 + q] : 0.f); imp[q * 256 + 8 * (tau) + k] = sred + add; } \
        else if (k == 7) carry[((tau) & 1) * 32 + q] = sred; } while (0)
        C2_ISSUE(0); C2_ISSUE(1); C2_ISSUE(2); C2_ISSUE(3);
        int T0w = 0;
        while (T0w < ntc && __all(bqC - sl * (float)(t - 31 - 512 * T0w - 64 * hh) - m_c < SKIP_LOG2)) ++T0w;
#pragma nounroll
        for (int T = 0; T < T0w; ++T) {
            WAITV_BAR(6);
            C2_ISSUE(T + 4);
            if (T > 0) C2_REDUCE(T - 1);
            LAS float* pw = part + (T & 1) * 4096 + (w * 32 + ql) * 16;
#pragma unroll
            for (int gg = 0; gg < 4; ++gg) *(LAS f32x2*)(pw + (2 * gg + hh) * 2) = (f32x2){0.f, 0.f};
        }
#pragma nounroll
        for (int T = T0w; T < ntc; ++T) {
            WAITV_BAR(6);
            LAS unsigned char* sb = tiles + (T % NSA_NS) * 16384;
            KFr kf; k_issue(kf, sb, g);
            C2_ISSUE(T + 4);
            if (T > 0) C2_REDUCE(T - 1);
            k_wait(kf);
            const int D0p = t - 31 - 512 * T - 64 * hh;
            f32x16 x = qk_raw<16>(kf, qf, sc16, D0p, hh, 1u << 30);
            VFr vf; v_issue(vf, sb + 8192, g);
            const float nb = -sl * (float)D0p - m_c;
#pragma unroll
            for (int i = 0; i < 16; ++i) x[i] = fexp2(x[i] + nb) * invl_c;
            LAS float* pw = part + (T & 1) * 4096 + (w * 32 + ql) * 16;
#pragma unroll
            for (int gg = 0; gg < 4; ++gg) { f32x2 v; v.x = (x[4 * gg] + x[4 * gg + 1]) + (x[4 * gg + 2] + x[4 * gg + 3]); v.y = x[4 * gg + 3]; *(LAS f32x2*)(pw + (2 * gg + hh) * 2) = v; }
            v_wait(vf);
            pv_mma(st, vf, x);
        }
        WAITV_BAR(0);
        C2_REDUCE(ntc - 1);
#undef C2_ISSUE
#undef C2_REDUCE
        W_ISSUE(0);
        NSA_STORE(0, 1.0f);
        WAITV_BAR(63);
    }
    for (int qi = 0; qi < 4; ++qi) {
        const int qq = 4 * w + qi;
        unsigned selm = 0u;
        if (cur <= 15) {
#pragma unroll
            for (int m = 0; m < 4; ++m) if (lane + 64 * m <= cur) selm |= 1u << m;
        } else {
            int sv[4];
#pragma unroll
            for (int m = 0; m < 4; ++m) { const int j = lane + 64 * m; sv[m] = (j >= 1 && j <= cur - 2) ? __float_as_int(imp[qq * 256 + j]) : -1; }
            int thr = 0;
#pragma nounroll
            for (int bit = 30; bit >= 0; --bit) {
                const int cand = thr | (1 << bit);
                const int cnt = __popcll(__ballot(sv[0] >= cand)) + __popcll(__ballot(sv[1] >= cand)) + __popcll(__ballot(sv[2] >= cand)) + __popcll(__ballot(sv[3] >= cand));
                thr = cnt >= 13 ? cand : thr;
            }
            int cgt = 0;
#pragma unroll
            for (int m = 0; m < 4; ++m) { const bool gt = sv[m] > thr; cgt += __popcll(__ballot(gt)); if (gt) selm |= 1u << m; }
            const int need = 13 - cgt; int before = 0;
#pragma unroll
            for (int m = 0; m < 4; ++m) { const bool eq = sv[m] == thr; const unsigned long long em = __ballot(eq);
                const int rank = before + (int)__builtin_amdgcn_mbcnt_hi((unsigned)(em >> 32), __builtin_amdgcn_mbcnt_lo((unsigned)em, 0u));
                if (eq && rank < need) selm |= 1u << m; before += __popcll(em); }
#pragma unroll
            for (int m = 0; m < 4; ++m) { const int j = lane + 64 * m; if (j == 0 || j == cur || j == cur - 1) selm |= 1u << m; }
        }
#pragma unroll
        for (int m = 0; m < 4; ++m) { const unsigned long long b = __ballot((selm >> m) & 1u); if (lane == 0) { sel[qq * 8 + 2 * m] = (unsigned)b; sel[qq * 8 + 2 * m + 1] = (unsigned)(b >> 32); } }
    }
    WAITV_BAR(63);
    if (w == 0) {
        unsigned o = 0u;
        if (lane < 8) { for (int q = 0; q < 32; ++q) o |= sel[q * 8 + lane]; }
        const int pc = __popc(o); int pre = 0;
#pragma unroll
        for (int k = 0; k < 7; ++k) { const int pk = __shfl(pc, k); if (lane > k) pre += pk; }
        if (lane < 8) { unsigned wv = o; int pos = pre; while (wv) { const int b = __builtin_ctz(wv); wv &= wv - 1; blist[pos++] = (unsigned)(32 * lane + b); } }
        if (lane == 7) uni[8] = (unsigned)(pre + pc);
    }
    WAITV_BAR(63);
    const f32x16 sc1 = make_sc<1>(sl);
    const float bqS = qn * kmax_of(kmx, 16 + gq) + sl * 31.0f, bqW = qn * kmax_of(kmx, 18 + gq) + sl * 31.0f;
    const f16* ksb = proj + C_KS + gq * 128 + (size_t)lr * NINP + lch * 8; const f16* vsb = proj + C_VS + gq * 128 + (size_t)lr * NINP + lch * 8;
    const int nblk = (int)uni[8];
#define S_ISSUE(I) do { const int b_ = (int)blist[(I) < nblk ? nblk - 1 - (I) : 0]; LAS unsigned char* sb_ = F.lds + 81920 + w * 1024 + ((I) & 1) * 32768; \
        _Pragma("unroll") for (int sub_ = 0; sub_ < 2; ++sub_) { const size_t ro = (size_t)(64 * b_ + 32 * sub_) * NINP; dma16(ksb + ro, sb_ + sub_ * 16384); dma16(vsb + ro, sb_ + sub_ * 16384 + 8192); } } while (0)
    S_ISSUE(0);
    {
        Att st; att_init(st);
#pragma nounroll
        for (int i = 0; 2 * i < nw; ++i) {
            WAITV_BAR(0);
            W_ISSUE(i + 1);
#pragma unroll
            for (int sub = 1; sub >= 0; --sub) {
                const int Tt = Tl - 2 * i - (1 - sub);
                const int D0p = t - 32 * Tt - 4 * hh;
                if (Tt >= Tf && !__all(bqW - sl * (float)D0p - st.m < SKIP_LOG2)) {
                    LAS unsigned char* sb = tiles + (i & 1) * 32768 + sub * 16384;
                    KFr kf; k_issue(kf, sb, g); k_wait(kf);
                    const f32x16 x = qk_raw<1>(kf, qf, sc1, D0p, hh, 511u);
                    att_online(st, sb + 8192, g, x, -sl * (float)D0p);
                }
            }
        }
#undef W_ISSUE
        const float lt = half_sum(st.l);
        NSA_STORE(2, 1.0f / lt);
    }
    {
        Att st; att_init(st);
        LAS unsigned char* tilesB = F.lds + 81920;
#pragma nounroll
        for (int i = 0; i < nblk; ++i) {
            WAITV_BAR(0);
            S_ISSUE(i + 1);
            const int b = (int)blist[nblk - 1 - i];
            const bool ok = (sel[ql * 8 + (b >> 5)] >> (b & 31)) & 1u;
#pragma unroll
            for (int sub = 1; sub >= 0; --sub) {
                const int kb = 64 * b + 32 * sub;
                const int D0p = t - kb - 4 * hh; const float bs = ok ? -sl * (float)D0p : -__builtin_inff();
                if (kb <= t0 + 31 && !__all(bqS + bs - st.m < SKIP_LOG2)) {
                    LAS unsigned char* sb = tilesB + (i & 1) * 32768 + sub * 16384;
                    KFr kf; k_issue(kf, sb, g); k_wait(kf);
                    const f32x16 x = qk_raw<1>(kf, qf, sc1, D0p, hh, 1u << 30);
                    att_online(st, sb + 8192, g, x, bs);
                }
            }
        }
#undef S_ISSUE
        asm volatile("s_waitcnt vmcnt(0)" ::: "memory");
        const float lt = half_sum(st.l);
        NSA_STORE(1, 1.0f / lt);
    }
#undef NSA_STORE
    WAITV_BAR(63);
}

struct P5Item { f16x8 a0[4], a1[4], a2[4], z[4]; float s0[4], s1[4], s2[4]; };
DEV void p5_load(Frame& F, P5Item& it, int item) {
    const int t = item >> 1, sideB = item & 1, lane = F.lane;
    const f16* proj = (const f16*)(F.ws + WS_PROJ) + (size_t)t * NINP;
    const f16* src = (const f16*)(F.ws + (sideB ? WS_OB : WS_OA)) + (size_t)t * DA;
    const float* lse = (const float*)(F.ws + WS_LSE) + (size_t)t * 16;
#pragma unroll
    for (int k = 0; k < 4; ++k) {
        const int col0 = 512 * k + 8 * lane, head = col0 >> 7;
        it.a0[k] = *(const f16x8*)(src + col0); it.a1[k] = *(const f16x8*)(src + (size_t)S * DA + col0); it.a2[k] = *(const f16x8*)(src + (size_t)2 * S * DA + col0);
        it.z[k] = *(const f16x8*)(proj + (sideB ? C_ZB : C_ZA) + col0);
        if (sideB) { const f16* gp = proj + C_GT + 3 * head; it.s0[k] = (float)gp[0]; it.s1[k] = (float)gp[1]; it.s2[k] = (float)gp[2]; }
        else { it.s0[k] = lse[head]; it.s1[k] = lse[(size_t)S * 16 + head]; it.s2[k] = lse[(size_t)2 * S * 16 + head]; }
    }
}
DEV void p5_compute(Frame& F, const P5Item& it, int item, int layer) {
    const int t = item >> 1, sideB = item & 1, lane = F.lane;
    const float* gg = (sideB ? F.og_b : F.og_a) + (size_t)layer * DA;
    float o[4][8]; float ss = 0.f;
#pragma unroll
    for (int k = 0; k < 4; ++k) {
        float w0, w1, w2;
        if (sideB) { w0 = 1.0f / (1.0f + fexp2(-LOG2E * it.s0[k])); w1 = 1.0f / (1.0f + fexp2(-LOG2E * it.s1[k])); w2 = 1.0f / (1.0f + fexp2(-LOG2E * it.s2[k])); }
        else { const float mx = fmaxf(it.s0[k], fmaxf(it.s1[k], it.s2[k])); w0 = fexp2(it.s0[k] - mx); w1 = fexp2(it.s1[k] - mx); w2 = fexp2(it.s2[k] - mx); const float inv = 1.0f / (w0 + w1 + w2); w0 *= inv; w1 *= inv; w2 *= inv; }
#pragma unroll
        for (int j = 0; j < 8; ++j) { o[k][j] = w0 * (float)it.a0[k][j] + w1 * (float)it.a1[k][j] + w2 * (float)it.a2[k][j]; ss += o[k][j] * o[k][j]; }
    }
    ss = wave_sum(ss);
    const float rs = 1.0f / sqrtf(ss * (1.0f / DA) + EPS);
    f16* y = (f16*)(F.ws + WS_Y) + (size_t)t * D + (sideB ? DA : 0);
#pragma unroll
    for (int k = 0; k < 4; ++k) {
        const int col0 = 512 * k + 8 * lane;
        const f32x4 g0 = *(const f32x4*)(gg + col0), g1 = *(const f32x4*)(gg + col0 + 4);
        float r[8];
#pragma unroll
        for (int j = 0; j < 8; ++j) { const float zz = (float)it.z[k][j]; const float gv = j < 4 ? g0[j & 3] : g1[j & 3]; r[j] = o[k][j] * rs * gv * (zz / (1.0f + fexp2(-LOG2E * zz))); }
        u32x4 wv; wv.x = pk2h(r[0], r[1]); wv.y = pk2h(r[2], r[3]); wv.z = pk2h(r[4], r[5]); wv.w = pk2h(r[6], r[7]);
        *(u32x4*)(y + col0) = wv;
    }
}
DEV void p5_finalize(Frame& F, int layer) {
    const bool grp = F.G == 256;
    const int xg = F.vcu >> 5, gw = grp ? 2048 * xg + NWAVES * (F.vcu & 31) + F.wave : F.vcu * NWAVES + F.wave, NGW = F.G * NWAVES;
    const int nj = grp ? 8 : (gw < S ? (S - gw + NGW - 1) / NGW : 0);
#define P5_ROW(j) (grp ? gw + 256 * (((j) + xg) & 7) : gw + NGW * (j))
    P5Item ia, ib;
    if (nj > 0) p5_load(F, ia, 2 * P5_ROW(0));
#pragma nounroll
    for (int j = 0; j < nj; ++j) {
        const int t = P5_ROW(j);
        p5_load(F, ib, 2 * t + 1);
        p5_compute(F, ia, 2 * t, layer);
        const int tn = j + 1 < nj ? P5_ROW(j + 1) : t;
        p5_load(F, ia, 2 * tn);
        p5_compute(F, ib, 2 * t + 1, layer);
    }
#undef P5_ROW
}

struct Args { const float* in[13]; float* out; unsigned char* ws; int ph_lo, ph_hi, fused, pad; };
constexpr int N_PHASES = 2 + 6 * DEPTH;

__global__ void __launch_bounds__(NTHR, 2) mega_fwd(Args args) {
    extern __shared__ __attribute__((aligned(16))) unsigned char lds_raw[];
    Frame F;
    F.lds = (LAS unsigned char*)lds_raw;
    F.tid = threadIdx.x; F.lane = F.tid & 63; F.wave = __builtin_amdgcn_readfirstlane(F.tid >> 6);
    F.G = gridDim.x; { const int bx = blockIdx.x; F.vcu = (F.G % 8 == 0) ? (bx % 8) * (F.G / 8) + bx / 8 : bx; }
    F.x = args.in[0]; F.norm_g = args.in[1]; F.w_in = args.in[2]; F.k_pe = args.in[3]; F.k_w1 = args.in[4]; F.k_w2 = args.in[5];
    F.v_pe = args.in[6]; F.v_w1 = args.in[7]; F.v_w2 = args.in[8]; F.og_a = args.in[9]; F.og_b = args.in[10]; F.w_out = args.in[11]; F.fin_g = args.in[12];
    F.out = args.out; F.ws = args.ws;
    volatile LAS unsigned* MISC = (volatile LAS unsigned*)(F.lds + MISC_OFF);
    if (F.tid < 32) MISC[F.tid] = 0u;
    __syncthreads();
    const bool fused = args.fused != 0;
    XcdBarrier bar; bar.bar = (unsigned*)(F.ws + WS_CTL) + CW_BAR; bar.x = 0; bar.st = nullptr;
    if (fused) bar = xcd_barrier_post((unsigned*)(F.ws + WS_CTL) + CW_BAR, MISC + 8);
    const int lo = args.ph_lo, hi = args.ph_hi;
    const bool grouped = F.G == 256;
    unsigned* gcnt = (unsigned*)(F.ws + WS_CTL) + CW_GRP + 64 * (F.vcu >> 5);
#define IN(k) (lo <= (k) && (k) < hi)
#define RETID() do { int _t = threadIdx.x; asm volatile("" : "+v"(_t)); F.tid = _t; F.lane = _t & 63; F.wave = __builtin_amdgcn_readfirstlane(_t >> 6); } while (0)
#define SEAM(k) do { if (fused && IN((k) + 1)) xcd_barrier(bar); } while (0)

    if (IN(0)) { RETID(); p0_prologue(F); SEAM(0); }

    for (int l = 0; l < DEPTH; ++l) {
        const int pb = 1 + 6 * l;
        if (IN(pb + 0)) { RETID(); if (l == 0) { p1_rownorm(F, F.x, (f16*)(F.ws + WS_H), (float*)(F.ws + WS_RS)); SEAM(pb + 0); } else if (!grouped) { p1_rowscale(F, (const float*)(F.ws + WS_RSP), (float*)(F.ws + WS_RS)); SEAM(pb + 0); } }
        if (IN(pb + 1)) {
            pg8::Gemm g{(const f16*)(F.ws + WS_H), (const f16*)(F.ws + WS_WIN) + (size_t)l * NINP * D, S, NINP, D};
            pg8::StaticOrder So; So.init(S, NINP, F.G, (int)blockIdx.x);
            pg8::EpiF16 E{(f16*)(F.ws + WS_PROJ), NINP, (const float*)(F.ws + WS_RS), (int*)(F.ws + WS_CTL) + CW_KMX + l * 96};
            if (grouped && l > 0) { RETID(); rowscale_tile(F, (const float*)(F.ws + WS_RSP), (float*)(F.ws + WS_RS), 8 * (F.vcu >> 5) + (F.vcu & 7)); }
            pg8::gemm_phase<pg8::EpiF16, pg8::StaticOrder, true, true>(F.lds, g, So, E);
            RETID(); backfill_wout(F, l);
            SEAM(pb + 1);
        }
        if (IN(pb + 2)) {
            const bool hasc = F.vcu < 128 && F.G == 256;
            if (F.G == 256) {
                if (hasc) { RETID(); cmp_unit(F, F.vcu, l); }
                RETID(); f16x8 qf[8]; load_q(qf, a_unit_qrow(F, F.vcu));
                constexpr int NC = 9;
                const int nu = hasc ? NC : 24 - NC;
                for (int k = 0; k < nu; ++k) {
                    const int u = k < 12 ? F.vcu + 256 * k : F.vcu - 128 + 256 * (NC + k - 12);
                    const int k1 = k + 1; const int un = k1 < nu ? (k1 < 12 ? F.vcu + 256 * k1 : F.vcu - 128 + 256 * (NC + k1 - 12)) : -1;
                    attn_a_unit(F, u, qf, un, l);
                }
            } else {
                for (int u = F.vcu; u < 128; u += F.G) { RETID(); cmp_unit(F, u, l); }
                RETID(); f16x8 qf[8]; load_q(qf, a_unit_qrow(F, F.vcu < 3072 ? F.vcu : 0));
                for (int u = F.vcu; u < 3072; u += F.G) { const int un = u + F.G < 3072 ? u + F.G : -1; attn_a_unit(F, u, qf, un, l); }
            }
        }
        if (IN(pb + 3)) {
            if (F.tid == 0) { unsigned* cd = (unsigned*)(F.ws + WS_CTL) + CW_CMPD + 64 * l; XB_SPIN(xb_ld(cd) < 128u, bar.bar); __builtin_amdgcn_fence(__ATOMIC_ACQUIRE, "agent"); asm volatile("s_waitcnt vmcnt(0)" ::: "memory"); }
            __syncthreads();
            for (int idx = F.vcu; idx < 1024; idx += F.G) {
                const int gq = (idx ^ (idx >> 8) ^ (idx >> 9)) & 1, k = idx >> 1, kq = k & 127, ki = k >> 7;
                const int chunk = ki == 0 ? kq : (ki == 1 ? 255 - kq : (ki == 2 ? 256 + kq : 511 - kq));
                RETID(); nsa_unit(F, chunk, gq, l);
            }
            SEAM(pb + 3);
        }
        if (IN(pb + 4)) { RETID(); p5_finalize(F, l); if (grouped) { if (fused && IN(pb + 5)) group_barrier(gcnt, 32u, bar.bar); } else SEAM(pb + 4); }
        if (IN(pb + 5)) {
            pg8::Gemm g{(const f16*)(F.ws + WS_Y), (const f16*)(F.ws + WS_WOUT) + (size_t)l * D * D, S, D, D};
            pg8::StaticOrder So; So.init(S, D, F.G, (int)blockIdx.x);
            pg8::EpiRes E{(f16*)(F.ws + WS_H), D, (l + 1 < DEPTH) ? (float*)(F.ws + WS_RSP) : nullptr};
            pg8::gemm_phase<pg8::EpiRes, pg8::StaticOrder, true, true>(F.lds, g, So, E);
            if (grouped) { if (fused && IN(pb + 6)) group_barrier(gcnt, 32u, bar.bar); } else SEAM(pb + 5);
        }
    }
    if (IN(N_PHASES - 1)) { RETID(); p_final(F, (const f16*)(F.ws + WS_H), F.fin_g, F.out); }
#undef IN
#undef SEAM
}

extern "C" void kernel_launch(void* const* d_in, const int* in_sizes, int n_in, void* d_out, int out_size, void* d_ws, size_t ws_size, hipStream_t stream) {
    static int grid = 0;
    if (grid == 0) {
        if (n_in != 13 || out_size != S * D || ws_size < WS_END) { fprintf(stderr, "kernel_launch: unexpected shapes (n_in %d out %d ws %zu)\n", n_in, out_size, ws_size); grid = -1; return; }
        int dev = 0, cus = 0, per_cu = 0;
        if (hipGetDevice(&dev) != hipSuccess || hipDeviceGetAttribute(&cus, hipDeviceAttributeMultiprocessorCount, dev) != hipSuccess) { grid = -1; return; }
        if (hipFuncSetAttribute((const void*)mega_fwd, hipFuncAttributeMaxDynamicSharedMemorySize, LDS_BYTES) != hipSuccess) { fprintf(stderr, "kernel_launch: hipFuncSetAttribute failed\n"); grid = -1; return; }
        if (hipOccupancyMaxActiveBlocksPerMultiprocessor(&per_cu, (const void*)mega_fwd, NTHR, LDS_BYTES) != hipSuccess || per_cu < 1) fprintf(stderr, "kernel_launch: occupancy query reports %d\n", per_cu);
        (void)hipGetLastError();
        grid = cus;
    }
    if (grid < 0) return;
    (void)hipMemsetAsync((char*)d_ws + WS_CTL, 0, CTL_ZERO_BYTES, stream);
    Args a{};
    for (int i = 0; i < 13; ++i) a.in[i] = (const float*)d_in[i];
    a.out = (float*)d_out; a.ws = (unsigned char*)d_ws; a.pad = 0;
#if MK_FUSED
    a.ph_lo = 0; a.ph_hi = N_PHASES; a.fused = 1;
    hipLaunchKernelGGL(mega_fwd, dim3(grid), dim3(NTHR), LDS_BYTES, stream, a);
#else
    for (int ph = 0; ph < N_PHASES; ++ph) { a.ph_lo = ph; a.ph_hi = ph + 1; a.fused = 0; hipLaunchKernelGGL(mega_fwd, dim3(grid), dim3(NTHR), LDS_BYTES, stream, a); }
#endif
}
```

```cpp
#include <hip/hip_runtime.h>
#include <cstdio>
#include <cstdint>

#ifndef MK_FUSED
#define MK_FUSED 1
#endif

#define LAS __attribute__((address_space(3)))
#define GAS __attribute__((address_space(1)))
#define DEV __device__ __forceinline__
typedef _Float16 f16;
typedef _Float16 f16x2 __attribute__((ext_vector_type(2)));
typedef _Float16 f16x4 __attribute__((ext_vector_type(4)));
typedef _Float16 f16x8 __attribute__((ext_vector_type(8)));
typedef short s16x4 __attribute__((ext_vector_type(4)));
typedef float f32x2 __attribute__((ext_vector_type(2)));
typedef float f32x4 __attribute__((ext_vector_type(4)));
typedef float f32x16 __attribute__((ext_vector_type(16)));
typedef unsigned u32x2 __attribute__((ext_vector_type(2)));
typedef unsigned u32x4 __attribute__((ext_vector_type(4)));

constexpr int S = 16384, D = 4096, DEPTH = 4, HD = 128;
constexpr int NIN = 13872, NINP = 14080;
constexpr int C_QA = 0, C_KA = 2048, C_VA = 4096, C_ZA = 6144, C_QB = 8192, C_KC = 10240, C_VC = 10496, C_KS = 10752, C_VS = 11008, C_KW = 11264, C_VW = 11520, C_ZB = 11776, C_GT = 13824;
constexpr int DA = 2048, DB = 2048;
constexpr float EPS = 1e-6f;
constexpr float LOG2E = 1.4426950408889634f;
constexpr float QSCALE2 = 0.08838834764831845f * 1.4426950408889634f;
constexpr int NWAVES = 8, NTHR = 512;

constexpr size_t MiB = 1u << 20;
constexpr size_t WS_CTL = 0, CTL_ZERO_BYTES = 1 * MiB;
constexpr size_t WS_WIN = 16 * MiB;
constexpr size_t WS_WOUT = 456 * MiB;
constexpr size_t WS_W1 = 584 * MiB;
constexpr size_t WS_W2 = 600 * MiB;
constexpr size_t WS_CMP = 602 * MiB;
constexpr size_t WS_LSE = 604 * MiB;
constexpr size_t WS_H = 608 * MiB;
constexpr size_t WS_PROJ = 736 * MiB;
constexpr size_t WS_OA = 1176 * MiB;
constexpr size_t WS_OB = 1368 * MiB;
constexpr size_t WS_Y = 1560 * MiB;
constexpr size_t WS_RS = 603 * MiB;
constexpr size_t WS_RSP = 1688 * MiB;
constexpr size_t WS_END = 1692 * MiB;
constexpr int CW_BAR = 4096;
constexpr int CW_CMPD = 32768;
constexpr int CW_GRP = 49152;
constexpr int CW_KMX = 16384;
constexpr float SKIP_LOG2 = -160.0f;

constexpr int RING_BYTES = 155648;
constexpr int MISC_OFF = RING_BYTES;
constexpr int LDS_BYTES = RING_BYTES + 1024;

#define LDS_WAIT() asm volatile("s_waitcnt lgkmcnt(0)" ::: "memory")
#define VM_WAIT() asm volatile("s_waitcnt vmcnt(0)" ::: "memory")

DEV unsigned pk2h(float lo, float hi) { f16x2 v = {(f16)lo, (f16)hi}; return __builtin_bit_cast(unsigned, v); }
DEV float wave_sum(float v) {
#pragma unroll
    for (int o = 1; o < 64; o <<= 1) v += __shfl_xor(v, o);
    return v;
}
DEV float fexp2(float x) { return __builtin_amdgcn_exp2f(x); }

#define XB_TMO      128
#define XB_XCNT(j)  (256  + 64 * (j))
#define XB_XSUB(j)  (1280 + 64 * (j))
#define XB_XGEN(j)  (2304 + 64 * (j))
#define XB_TOP      3328
#define XB_TOPGEN   3392
#define XCD_BAR_WORDS 3456
#define XB_SPIN_CAP (1u << 18)
__device__ __forceinline__ unsigned xb_ld(unsigned* p)              { return __hip_atomic_load(p, __ATOMIC_RELAXED, __HIP_MEMORY_SCOPE_AGENT); }
__device__ __forceinline__ unsigned xb_add(unsigned* p, unsigned v) { return __hip_atomic_fetch_add(p, v, __ATOMIC_RELAXED, __HIP_MEMORY_SCOPE_AGENT); }
__device__ __forceinline__ unsigned xb_xcc_id() { return (unsigned)__builtin_amdgcn_s_getreg((3 << 11) | 20) & 0xFu; }
#define XB_SPIN(cond, bar) do { unsigned _sp = 0; while (cond) { __builtin_amdgcn_s_sleep(1); \
    if ((++_sp & 255u) == 0u) { if (xb_ld(&(bar)[XB_TMO])) break; if (_sp > XB_SPIN_CAP) { atomicAdd(&(bar)[XB_TMO], 1u); break; } } } } while (0)
struct XcdBarrier { unsigned* bar; unsigned x; volatile LAS unsigned* st; };
__device__ __forceinline__ XcdBarrier xcd_barrier_post(unsigned* bar, volatile LAS unsigned* st) {
    XcdBarrier b; b.bar = bar; b.x = xb_xcc_id(); b.st = st;
    if (threadIdx.x == 0) (void)xb_add(&bar[XB_XCNT(b.x)], 1u);
    return b;
}
__device__ __forceinline__ void xcd_barrier_complete(unsigned* bar, unsigned x, unsigned& nloc, unsigned& nx) {
    const unsigned G = gridDim.x * gridDim.y * gridDim.z;
    unsigned sum, cnt, mine, sp = 0u;
    for (;;) {
        sum = 0u; cnt = 0u; mine = 0u;
#pragma unroll
        for (unsigned j = 0; j < 16; ++j) { const unsigned c = xb_ld(&bar[XB_XCNT(j)]); sum += c; cnt += (c > 0u) ? 1u : 0u; mine = (j == x) ? c : mine; }
        if (sum == G) break;
        __builtin_amdgcn_s_sleep(1);
        if ((++sp & 255u) == 0u) { if (xb_ld(&bar[XB_TMO])) break; if (sp > XB_SPIN_CAP) { atomicAdd(&bar[XB_TMO], 1u); break; } }
    }
    nloc = mine > 0u ? mine : 1u; nx = cnt > 0u ? cnt : 1u;
}
__device__ __forceinline__ void xcd_barrier(const XcdBarrier& b) {
    asm volatile("s_waitcnt vmcnt(0)" ::: "memory");
    __syncthreads();
    if (threadIdx.x == 0) {
        unsigned* bar = b.bar;
        __builtin_amdgcn_s_waitcnt(0);
        unsigned nloc = b.st[0], nx = b.st[1];
        if (nloc == 0u) { xcd_barrier_complete(bar, b.x, nloc, nx); b.st[0] = nloc; b.st[1] = nx; }
        const unsigned old = xb_add(&bar[XB_XSUB(b.x)], 1u);
        const unsigned gen = old / nloc;
        if (old + 1u == (gen + 1u) * nloc) {
            __builtin_amdgcn_fence(__ATOMIC_RELEASE, "agent");
            asm volatile("s_waitcnt vmcnt(0)" ::: "memory");
            const unsigned og = xb_add(&bar[XB_TOP], 1u);
            const unsigned tg = og / nx;
            if (og + 1u == (tg + 1u) * nx) xb_add(&bar[XB_TOPGEN], 1u);
            else XB_SPIN(xb_ld(&bar[XB_TOPGEN]) == tg, bar);
            __builtin_amdgcn_fence(__ATOMIC_ACQUIRE, "agent");
            xb_add(&bar[XB_XGEN(b.x)], 1u);
            asm volatile("s_waitcnt vmcnt(0)" ::: "memory");
        } else {
            XB_SPIN(xb_ld(&bar[XB_XGEN(b.x)]) == gen, bar);
            __builtin_amdgcn_fence(__ATOMIC_ACQUIRE, "agent");
            asm volatile("s_waitcnt vmcnt(0)" ::: "memory");
        }
    }
    __syncthreads();
}

__device__ __forceinline__ void group_barrier(unsigned* cnt, unsigned gsz, unsigned* bar) {
    asm volatile("s_waitcnt vmcnt(0)" ::: "memory");
    __syncthreads();
    if (threadIdx.x == 0) {
        __builtin_amdgcn_fence(__ATOMIC_RELEASE, "agent");
        asm volatile("s_waitcnt vmcnt(0)" ::: "memory");
        const unsigned old = xb_add(cnt, 1u);
        const unsigned target = (old / gsz + 1u) * gsz;
        XB_SPIN(xb_ld(cnt) < target, bar);
        __builtin_amdgcn_fence(__ATOMIC_ACQUIRE, "agent");
        asm volatile("s_waitcnt vmcnt(0)" ::: "memory");
    }
    __syncthreads();
}

namespace pg8 {
constexpr int BM = 256, BK = 64, HALF = 128, HTB = HALF * BK * 2, STAGE_BYTES = 8 * HTB, NXCD = 8, WGM = 8;
__host__ __device__ __forceinline__ int lds_byte(int r, int c) { const int st = (r >> 4) * 2 + (c >> 5), rr = r & 15, cc = c & 31, ob = rr * 64 + cc * 2; return st * 1024 + (ob ^ (((ob >> 9) & 1) << 5)); }
__host__ __device__ __forceinline__ void stage_rc(int b, int& R, int& C) { const int st = b / 1024, sb = b % 1024, swz = sb ^ (((sb >> 9) & 1) << 5); R = (st >> 1) * 16 + swz / 64; C = (st & 1) * 32 + (swz % 64) / 2; }
__host__ __device__ __forceinline__ int perm32(int rho) { const int n = rho >> 4, i = rho & 15; return 8 * (i >> 2) + 4 * n + (i & 3); }
struct Unit { int pm, pn; };
struct Gemm { const f16* A; const f16* Bt; int M, N, K; };
struct StaticOrder {
    int nM, nN, nwg, G, c;
    __device__ void init(int M, int N, int G_, int c_) { nM = M / BM; nN = N / BM; nwg = nM * nN; G = G_; c = c_; }
    __device__ bool next(int i, Unit& u) const {
        const long L = (long)i * G + c; if (L >= nwg) return false;
        int wgid = (int)L; { const int q = nwg / NXCD, r = nwg % NXCD, xcd = wgid % NXCD, off = wgid / NXCD; wgid = (xcd < r ? xcd * (q + 1) : r * (q + 1) + (xcd - r) * q) + off; }
        const int nig = WGM * nN, gid = wgid / nig, fm = gid * WGM, gsz = (nM - fm) < WGM ? (nM - fm) : WGM;
        u.pm = fm + ((wgid % nig) % gsz); u.pn = (wgid % nig) / gsz; return true;
    }
    __device__ __forceinline__ void a_ready(const Unit&) const {}
    __device__ __forceinline__ void done(const Unit&) const {}
};
struct EpiF16 {
    static constexpr bool PERM = true, AFTER_DRAIN = false;
    f16* O; int ldc; const float* rs; int* kmx;
    __device__ __forceinline__ void operator()(const f32x4 (&acc)[2][2][4][2], const Unit& u, int wr, int wc, int fr, int fq) const {
        const int row0 = u.pm * BM + wr * 64 + fr; const int col0 = u.pn * BM + wc * 32 + 8 * fq;
        const int kslot = (u.pn >= 8 && u.pn < 16) ? 2 * (u.pn - 8) : (u.pn == 42 ? 16 : (u.pn == 44 ? 18 : -1));
        float rmax[2] = {0.f, 0.f};
#pragma unroll
        for (int ai = 0; ai < 2; ++ai)
#pragma unroll
            for (int m = 0; m < 4; ++m) { const int row = row0 + ai * HALF + m * 16; f16* rowp = O + (size_t)row * ldc + col0; const float sc = rs[row];
#pragma unroll
                for (int bj = 0; bj < 2; ++bj) { const f32x4 v0 = acc[ai][bj][m][0] * sc, v1 = acc[ai][bj][m][1] * sc;
                    u32x4 w; w.x = pk2h(v0[0], v0[1]); w.y = pk2h(v0[2], v0[3]); w.z = pk2h(v1[0], v1[1]); w.w = pk2h(v1[2], v1[3]);
                    *(u32x4*)(rowp + bj * HALF) = w;
                    if (kslot >= 0) { float s8 = ((v0[0] * v0[0] + v0[1] * v0[1]) + (v0[2] * v0[2] + v0[3] * v0[3])) + ((v1[0] * v1[0] + v1[1] * v1[1]) + (v1[2] * v1[2] + v1[3] * v1[3]));
                        s8 += __shfl_xor(s8, 16); s8 += __shfl_xor(s8, 32); rmax[bj] = fmaxf(rmax[bj], s8); } } }
        if (kslot >= 0) {
#pragma unroll
            for (int bj = 0; bj < 2; ++bj) { float v = rmax[bj];
#pragma unroll
                for (int o = 1; o < 16; o <<= 1) v = fmaxf(v, __shfl_xor(v, o));
                if (fr == 0 && fq == 0) atomicMax(kmx + (kslot + bj) * 4 + wc, __float_as_int(v * 1.004f)); }
        }
    }
};
struct EpiRes {
    static constexpr bool PERM = true, AFTER_DRAIN = false;
    f16* X; int ldc; float* ssp;
    __device__ __forceinline__ void operator()(const f32x4 (&acc)[2][2][4][2], const Unit& u, int wr, int wc, int fr, int fq) const {
        const int row0 = u.pm * BM + wr * 64 + fr, col0 = u.pn * BM + wc * 32 + 8 * fq;
#pragma unroll
        for (int ai = 0; ai < 2; ++ai)
#pragma unroll
            for (int m = 0; m < 4; ++m) { const int row = row0 + ai * HALF + m * 16; f16* rowp = X + (size_t)row * ldc + col0; float ss = 0.f;
#pragma unroll
                for (int bj = 0; bj < 2; ++bj) { const f16x8 xo = *(const f16x8*)(rowp + bj * HALF); f32x4 v0 = acc[ai][bj][m][0], v1 = acc[ai][bj][m][1];
                    v0[0] += (float)xo[0]; v0[1] += (float)xo[1]; v0[2] += (float)xo[2]; v0[3] += (float)xo[3]; v1[0] += (float)xo[4]; v1[1] += (float)xo[5]; v1[2] += (float)xo[6]; v1[3] += (float)xo[7];
                    ss += ((v0[0] * v0[0] + v0[1] * v0[1]) + (v0[2] * v0[2] + v0[3] * v0[3])) + ((v1[0] * v1[0] + v1[1] * v1[1]) + (v1[2] * v1[2] + v1[3] * v1[3]));
                    u32x4 w; w.x = pk2h(v0[0], v0[1]); w.y = pk2h(v0[2], v0[3]); w.z = pk2h(v1[0], v1[1]); w.w = pk2h(v1[2], v1[3]);
                    *(u32x4*)(rowp + bj * HALF) = w; }
                if (ssp) { ss += __shfl_xor(ss, 16); ss += __shfl_xor(ss, 32);
                    if (fq == 0) ssp[(size_t)row * 64 + u.pn * 4 + wc] = ss; } }
    }
};

template <class Epi, class Sched, bool ALIGN_EPI = false, bool SP2 = false>
__device__ __forceinline__ void gemm_phase(LAS unsigned char* lds, const Gemm g, const Sched& S, const Epi& E) {
    int tid = threadIdx.x; asm volatile("" : "+v"(tid));
    const int wid = __builtin_amdgcn_readfirstlane(tid >> 6), lane = tid & 63, wr = wid >> 2, wc = wid & 3, fr = lane & 15, fq = lane >> 4;
    const int K = g.K, nt = K / BK;
    unsigned voffA[2], voffB[2];
#pragma unroll
    for (int i = 0; i < 2; ++i) { int R, C; stage_rc(tid * 16 + i * 8192, R, C); const int Rb = Epi::PERM ? ((R & ~31) + perm32(R & 31)) : R;
        voffA[i] = (unsigned)(R * K + C) * 2u; voffB[i] = (unsigned)(Rb * K + C) * 2u; }
    const size_t kstep = (size_t)(BK * 2);
    const size_t hstep = (size_t)HALF * K * 2;
    const size_t tstep = 2 * hstep;
    const unsigned ldsw = (unsigned)wid * 1024u;
    const int aoff = lds_byte(wr * 64 + fr, fq * 8), boff = lds_byte(wc * 32 + fr, fq * 8);
#define PG8_SA(b, h) (((b) * 2 + (h)) * HTB)
#define PG8_SB(b, h) ((4 + (b) * 2 + (h)) * HTB)
#define PG8_STAGE(bufoff, gbase, voff) do { _Pragma("unroll") for (int _i = 0; _i < 2; ++_i) \
        __builtin_amdgcn_global_load_lds((const unsigned*)((const char*)(gbase) + (voff)[_i]), (LAS unsigned*)(lds + (bufoff) + ldsw + _i * 8192), 16, 0, 0); } while (0)
#define PG8_LDA(dst, b, h) do { _Pragma("unroll") for (int m = 0; m < 4; ++m) _Pragma("unroll") for (int k = 0; k < 2; ++k) dst[m][k] = *(const LAS f16x8*)(lds + PG8_SA(b, h) + aoff + m * 2048 + k * 1024); } while (0)
#define PG8_LDB(dst, b, h) do { _Pragma("unroll") for (int n = 0; n < 2; ++n) _Pragma("unroll") for (int k = 0; k < 2; ++k) dst[n][k] = *(const LAS f16x8*)(lds + PG8_SB(b, h) + boff + n * 2048 + k * 1024); } while (0)
#define PG8_MMA(ai, bj, At, Bt) do { __builtin_amdgcn_s_setprio(1); _Pragma("unroll") for (int m = 0; m < 4; ++m) _Pragma("unroll") for (int n = 0; n < 2; ++n) _Pragma("unroll") for (int k = 0; k < 2; ++k) \
        acc[ai][bj][m][n] = __builtin_amdgcn_mfma_f32_16x16x32_f16(Bt[n][k], At[m][k], acc[ai][bj][m][n], 0, 0, 0); __builtin_amdgcn_s_setprio(0); } while (0)
#define PG8_WAIT_V(n) asm volatile("s_waitcnt vmcnt(" #n ")" ::: "memory")
#define PG8_WAIT_L(n) asm volatile("s_waitcnt lgkmcnt(" #n ")" ::: "memory")
#define PG8_BAR __builtin_amdgcn_s_barrier()
#define PG8_SCHED __builtin_amdgcn_sched_barrier(0)
    Unit cur, nxt; int ui = 0;
    if (!S.next(0, cur)) return;
    f32x4 acc[2][2][4][2];
#pragma unroll
    for (int a = 0; a < 2; ++a)
#pragma unroll
        for (int b = 0; b < 2; ++b)
#pragma unroll
            for (int m = 0; m < 4; ++m)
#pragma unroll
                for (int n = 0; n < 2; ++n) acc[a][b][m][n] = (f32x4){0.f, 0.f, 0.f, 0.f};
    f16x8 At[4][2], B0[2][2], B1[2][2];
    const char* cA = (const char*)g.A + (size_t)cur.pm * tstep; const char* cB = (const char*)g.Bt + (size_t)cur.pn * tstep;
    S.a_ready(cur);
    if constexpr (SP2) {
        PG8_STAGE(PG8_SB(0, 0), cB, voffB); PG8_STAGE(PG8_SB(0, 1), cB + hstep, voffB); PG8_STAGE(PG8_SA(0, 0), cA, voffA); PG8_STAGE(PG8_SA(0, 1), cA + hstep, voffA);
        if (wr == 1) PG8_BAR;
        PG8_WAIT_V(2); PG8_BAR;
        PG8_STAGE(PG8_SB(1, 0), cB + kstep, voffB); PG8_STAGE(PG8_SA(1, 0), cA + kstep, voffA); PG8_STAGE(PG8_SB(1, 1), cB + hstep + kstep, voffB);
        PG8_WAIT_V(6); PG8_BAR;
    } else {
        PG8_STAGE(PG8_SB(0, 0), cB, voffB); PG8_STAGE(PG8_SA(0, 0), cA, voffA); PG8_STAGE(PG8_SB(0, 1), cB + hstep, voffB); PG8_STAGE(PG8_SA(0, 1), cA + hstep, voffA);
        if (wr == 1) PG8_BAR;
        PG8_WAIT_V(4); PG8_BAR;
        PG8_STAGE(PG8_SB(1, 0), cB + kstep, voffB); PG8_STAGE(PG8_SA(1, 0), cA + kstep, voffA); PG8_STAGE(PG8_SB(1, 1), cB + hstep + kstep, voffB);
        PG8_WAIT_V(6); PG8_BAR;
    }
    for (;;) {
        const bool has_next = S.next(ui + 1, nxt);
        const char* nA = has_next ? (const char*)g.A + (size_t)nxt.pm * tstep : cA; const char* nB = has_next ? (const char*)g.Bt + (size_t)nxt.pn * tstep : cB;
        for (int t = 0; t < nt; t += 2) {
            const bool last = (t == nt - 2);
            const char* a1 = cA + (size_t)(t + 1) * kstep;
            const char* a2 = last ? nA : cA + (size_t)(t + 2) * kstep; const char* b2 = last ? nB : cB + (size_t)(t + 2) * kstep;
            const char* a3 = a2 + kstep; const char* b3 = b2 + kstep;
            if (last && has_next) S.a_ready(nxt);
            if constexpr (SP2) {
            PG8_LDB(B0, 0, 0); PG8_LDB(B1, 0, 1); PG8_SCHED; PG8_LDA(At, 0, 0); PG8_STAGE(PG8_SA(1, 1), a1 + hstep, voffA);
            PG8_WAIT_V(8); PG8_WAIT_L(0); PG8_BAR; PG8_MMA(0, 0, At, B0); PG8_MMA(0, 1, At, B1); PG8_BAR; PG8_SCHED;
            PG8_LDA(At, 0, 1); PG8_STAGE(PG8_SB(0, 0), b2, voffB); PG8_STAGE(PG8_SB(0, 1), b2 + hstep, voffB); PG8_STAGE(PG8_SA(0, 0), a2, voffA);
            PG8_WAIT_V(8); PG8_WAIT_L(0); PG8_BAR; PG8_MMA(1, 0, At, B0); PG8_MMA(1, 1, At, B1); PG8_BAR; PG8_SCHED;
            PG8_LDB(B0, 1, 0); PG8_LDB(B1, 1, 1); PG8_SCHED; PG8_LDA(At, 1, 0); PG8_STAGE(PG8_SA(0, 1), a2 + hstep, voffA);
            PG8_WAIT_V(8); PG8_WAIT_L(0); PG8_BAR; PG8_MMA(0, 0, At, B0); PG8_MMA(0, 1, At, B1); PG8_BAR; PG8_SCHED;
            PG8_LDA(At, 1, 1); PG8_STAGE(PG8_SB(1, 0), b3, voffB); PG8_STAGE(PG8_SB(1, 1), b3 + hstep, voffB); PG8_STAGE(PG8_SA(1, 0), a3, voffA);
            PG8_WAIT_V(8); PG8_WAIT_L(0); PG8_BAR; PG8_MMA(1, 0, At, B0); PG8_MMA(1, 1, At, B1); PG8_BAR; PG8_SCHED;
            } else {
            PG8_LDB(B0, 0, 0); PG8_SCHED; PG8_LDA(At, 0, 0); PG8_STAGE(PG8_SA(1, 1), a1 + hstep, voffA);
            PG8_WAIT_L(8); PG8_BAR; PG8_WAIT_L(0); PG8_MMA(0, 0, At, B0); PG8_BAR; PG8_SCHED;
            PG8_LDB(B1, 0, 1); PG8_STAGE(PG8_SB(0, 0), b2, voffB);
            PG8_BAR; PG8_WAIT_L(0); PG8_MMA(0, 1, At, B1); PG8_BAR;
            PG8_LDA(At, 0, 1); PG8_STAGE(PG8_SA(0, 0), a2, voffA);
            PG8_BAR; PG8_WAIT_L(0); PG8_MMA(1, 0, At, B0); PG8_BAR; PG8_SCHED;
            PG8_STAGE(PG8_SB(0, 1), b2 + hstep, voffB);
            PG8_WAIT_V(6); PG8_BAR; PG8_MMA(1, 1, At, B1); PG8_BAR;
            PG8_LDB(B0, 1, 0); PG8_SCHED; PG8_LDA(At, 1, 0); PG8_STAGE(PG8_SA(0, 1), a2 + hstep, voffA);
            PG8_WAIT_L(8); PG8_BAR; PG8_WAIT_L(0); PG8_MMA(0, 0, At, B0); PG8_BAR; PG8_SCHED;
            PG8_LDB(B1, 1, 1); PG8_STAGE(PG8_SB(1, 0), b3, voffB);
            PG8_BAR; PG8_WAIT_L(0); PG8_MMA(0, 1, At, B1); PG8_BAR;
            PG8_LDA(At, 1, 1); PG8_STAGE(PG8_SA(1, 0), a3, voffA);
            PG8_BAR; PG8_WAIT_L(0); PG8_MMA(1, 0, At, B0); PG8_BAR; PG8_SCHED;
            PG8_STAGE(PG8_SB(1, 1), b3 + hstep, voffB);
            PG8_WAIT_V(6); PG8_BAR; PG8_MMA(1, 1, At, B1); PG8_BAR;
            }
        }
        if constexpr (ALIGN_EPI) { if (wr == 0) PG8_BAR; }
        if constexpr (!Epi::AFTER_DRAIN) { E(acc, cur, wr, wc, fr, fq); S.done(cur); }
        if (!has_next) break;
#pragma unroll
        for (int a = 0; a < 2; ++a)
#pragma unroll
            for (int b = 0; b < 2; ++b)
#pragma unroll
                for (int m = 0; m < 4; ++m)
#pragma unroll
                    for (int n = 0; n < 2; ++n) acc[a][b][m][n] = (f32x4){0.f, 0.f, 0.f, 0.f};
        cur = nxt; cA = nA; cB = nB; ++ui;
        if constexpr (ALIGN_EPI) { if (wr == 1) PG8_BAR; }
    }
    PG8_WAIT_V(0);
    if constexpr (!ALIGN_EPI) { if (wr == 0) PG8_BAR; }
    PG8_BAR;
#undef PG8_SA
#undef PG8_SB
#undef PG8_STAGE
#undef PG8_LDA
#undef PG8_LDB
#undef PG8_MMA
#undef PG8_WAIT_V
#undef PG8_WAIT_L
#undef PG8_BAR
#undef PG8_SCHED
}
}

struct Frame {
    LAS unsigned char* lds;
    int tid, lane, wave, vcu, G;
    const float *x, *norm_g, *w_in, *k_pe, *k_w1, *k_w2, *v_pe, *v_w1, *v_w2, *og_a, *og_b, *w_out, *fin_g;
    float* out;
    unsigned char* ws;
};

DEV void transpose_item(const float* W, int K, int N, f16* WT, LAS float* scr, int kb, int nb, int lane, const float* gk = nullptr) {
    const int k0 = 64 * kb, n0 = 32 * nb; const int nn = n0 + (lane & 31); const bool inb = nn < N;
    float tv[32];
#pragma unroll
    for (int i = 0; i < 32; ++i) { const int kk = 2 * i + (lane >> 5); tv[i] = inb ? W[(size_t)(k0 + kk) * N + nn] : 0.f; }
    if (gk) {
#pragma unroll
        for (int i = 0; i < 32; ++i) tv[i] *= gk[k0 + 2 * i + (lane >> 5)]; }
#pragma unroll
    for (int i = 0; i < 32; ++i) { const int kk = 2 * i + (lane >> 5); scr[kk * 33 + (lane & 31)] = tv[i]; }
    LDS_WAIT(); asm volatile("" ::: "memory");
    const int c = lane & 7;
#pragma unroll
    for (int j = 0; j < 4; ++j) { const int n = (lane >> 3) + 8 * j; const LAS float* s = scr + (8 * c) * 33 + n;
        u32x4 o; o.x = pk2h(s[0 * 33], s[1 * 33]); o.y = pk2h(s[2 * 33], s[3 * 33]); o.z = pk2h(s[4 * 33], s[5 * 33]); o.w = pk2h(s[6 * 33], s[7 * 33]);
        *(u32x4*)(WT + (size_t)(n0 + n) * K + k0 + 8 * c) = o; }
    LDS_WAIT(); asm volatile("" ::: "memory");
}
DEV void p0_prologue(Frame& F) {
    LAS float* scr = (LAS float*)(F.lds + F.wave * 16384);
    const int gw = F.vcu * NWAVES + F.wave, NGW = F.G * NWAVES;
    constexpr int I_IN = 64 * (NINP / 32), I_W1 = 64 * 8, I_W2 = 4 * 4;
    constexpr int PER_L = I_IN + 2 * I_W1 + 2 * I_W2;
    for (int it = gw; it < DEPTH * PER_L; it += NGW) {
        const int l = it / PER_L; int r = it % PER_L;
        if (r < I_IN) { transpose_item(F.w_in + (size_t)l * D * NIN, D, NIN, (f16*)(F.ws + WS_WIN) + (size_t)l * NINP * D, scr, r / (NINP / 32), r % (NINP / 32), F.lane, F.norm_g + (size_t)l * D); continue; } r -= I_IN;
        if (r < 2 * I_W1) { const int kv = r / I_W1; r %= I_W1; transpose_item((kv ? F.v_w1 : F.k_w1) + (size_t)l * 4096 * 256, 4096, 256, (f16*)(F.ws + WS_W1) + (size_t)(l * 2 + kv) * 256 * 4096, scr, r / 8, r % 8, F.lane); continue; } r -= 2 * I_W1;
        { const int kv = r / I_W2; r %= I_W2; transpose_item((kv ? F.v_w2 : F.k_w2) + (size_t)l * 256 * 128, 256, 128, (f16*)(F.ws + WS_W2) + (size_t)(l * 2 + kv) * 128 * 256, scr, r / 4, r % 4, F.lane); }
    }
}

DEV void backfill_wout(Frame& F, int l) {
    const int nwg = (S / 256) * (NINP / 256), nw = nwg % F.G, c = (int)blockIdx.x;
    if (nw != 0 && c < nw) return;
    const int nid = nw ? F.G - nw : F.G, me = nw ? c - nw : c;
    LAS float* scr = (LAS float*)(F.lds + F.wave * 16384);
    constexpr int I_OUT = 64 * (D / 32);
    for (int r = me * NWAVES + F.wave; r < I_OUT; r += nid * NWAVES)
        transpose_item(F.w_out + (size_t)l * D * D, D, D, (f16*)(F.ws + WS_WOUT) + (size_t)l * D * D, scr, r / (D / 32), r % (D / 32), F.lane);
}

DEV void p1_rownorm(Frame& F, const float* xin, f16* h, float* rs) {
    const int gw = F.vcu * NWAVES + F.wave, NGW = F.G * NWAVES;
    for (int row = gw; row < S; row += NGW) {
        const f32x4* xr = (const f32x4*)(xin + (size_t)row * D) + F.lane;
        f32x4 v[16]; float ss = 0.f;
#pragma unroll
        for (int j = 0; j < 16; ++j) { v[j] = xr[64 * j]; ss += (v[j].x * v[j].x + v[j].y * v[j].y) + (v[j].z * v[j].z + v[j].w * v[j].w); }
        ss = wave_sum(ss);
        if (F.lane == 0) rs[row] = 1.0f / sqrtf(ss * (1.0f / D) + EPS);
        u32x2* o = (u32x2*)(h + (size_t)row * D) + F.lane;
#pragma unroll
        for (int j = 0; j < 16; ++j) { u32x2 w; w.x = pk2h(v[j].x, v[j].y); w.y = pk2h(v[j].z, v[j].w); o[64 * j] = w; }
    }
}
DEV void p1_rowscale(Frame& F, const float* ssp, float* rs) {
    for (int row = F.vcu * NTHR + F.tid; row < S; row += F.G * NTHR) {
        const f32x4* p = (const f32x4*)(ssp + (size_t)row * 64); float ss = 0.f;
#pragma unroll
        for (int j = 0; j < 16; ++j) { const f32x4 v = p[j]; ss += (v.x + v.y) + (v.z + v.w); }
        rs[row] = 1.0f / sqrtf(ss * (1.0f / D) + EPS);
    }
}
DEV void rowscale_tile(Frame& F, const float* ssp, float* rs, int pm) {
    if (F.tid < 256) { const int row = pm * 256 + F.tid;
        const f32x4* p = (const f32x4*)(ssp + (size_t)row * 64); float ss = 0.f;
#pragma unroll
        for (int j = 0; j < 16; ++j) { const f32x4 v = p[j]; ss += (v.x + v.y) + (v.z + v.w); }
        rs[row] = 1.0f / sqrtf(ss * (1.0f / D) + EPS); }
    asm volatile("s_waitcnt vmcnt(0)" ::: "memory");
    __syncthreads();
}
DEV void p_final(Frame& F, const f16* xin, const float* g, float* out) {
    const bool grp = F.G == 256;
    const int xg = F.vcu >> 5, gw = grp ? 2048 * xg + NWAVES * (F.vcu & 31) + F.wave : F.vcu * NWAVES + F.wave, NGW = F.G * NWAVES;
    const int nj = grp ? 8 : (gw < S ? (S - gw + NGW - 1) / NGW : 0);
    for (int j = 0; j < nj; ++j) { const int row = grp ? gw + 256 * ((j + xg) & 7) : gw + NGW * j;
        const f16x8* xr = (const f16x8*)(xin + (size_t)row * D) + F.lane;
        f16x8 v[8]; float ss = 0.f;
#pragma unroll
        for (int j = 0; j < 8; ++j) { v[j] = xr[64 * j];
#pragma unroll
            for (int e = 0; e < 8; ++e) ss += (float)v[j][e] * (float)v[j][e]; }
        ss = wave_sum(ss);
        const float rs = 1.0f / sqrtf(ss * (1.0f / D) + EPS);
#pragma unroll
        for (int j = 0; j < 8; ++j) { const int c0 = 8 * (F.lane + 64 * j); const f32x4 g0 = *(const f32x4*)(g + c0), g1 = *(const f32x4*)(g + c0 + 4);
            f32x4 o0, o1; o0.x = (float)v[j][0] * rs * g0.x; o0.y = (float)v[j][1] * rs * g0.y; o0.z = (float)v[j][2] * rs * g0.z; o0.w = (float)v[j][3] * rs * g0.w;
            o1.x = (float)v[j][4] * rs * g1.x; o1.y = (float)v[j][5] * rs * g1.y; o1.z = (float)v[j][6] * rs * g1.z; o1.w = (float)v[j][7] * rs * g1.w;
            *(f32x4*)(out + (size_t)row * D + c0) = o0; *(f32x4*)(out + (size_t)row * D + c0 + 4) = o1; }
    }
}

DEV unsigned offa(unsigned row, unsigned ch) { return 2048u * (row >> 3) + 512u * (ch >> 2) + 64u * (row & 7u) + 16u * ((ch & 3u) ^ ((row >> 2) & 3u)); }
struct Geo { unsigned kb0, kb1, vb0, vb1; };
DEV Geo make_geo(int lane) {
    Geo g; const unsigned r = lane & 31, hh = lane >> 5, Y = (r >> 2) & 3u;
    const unsigned kb = 2048u * (r >> 3) + 64u * (r & 7u);
    g.kb0 = kb + 16u * (2u * (Y >> 1) + (hh ^ (Y & 1u)));
    g.kb1 = kb + 16u * (2u * (1u ^ (Y >> 1)) + (hh ^ (Y & 1u)));
    const unsigned blk = (lane >> 4) & 1, q = (lane & 15) >> 2, p = lane & 3;
    const unsigned vb = 64u * (4u * hh + q) + 8u * (p & 1u) + 16u * ((p >> 1) ^ hh);
    g.vb0 = vb + 32u * blk;
    g.vb1 = vb + 32u * (blk ^ 1u) + 2048u;
    return g;
}
struct Att { f32x16 acc[4]; float m, l; };
DEV void att_init(Att& a) {
#pragma unroll
    for (int c = 0; c < 4; ++c)
#pragma unroll
        for (int i = 0; i < 16; ++i) a.acc[c][i] = 0.f;
    a.m = -1e30f; a.l = 0.f;
}
DEV float half_max(float v) { auto rr = __builtin_amdgcn_permlane32_swap(__float_as_uint(v), __float_as_uint(v), false, false); return fmaxf(__uint_as_float(rr[0]), __uint_as_float(rr[1])); }
DEV float half_sum(float v) { auto rr = __builtin_amdgcn_permlane32_swap(__float_as_uint(v), __float_as_uint(v), false, false); return __uint_as_float(rr[0]) + __uint_as_float(rr[1]); }

struct KFr { f16x8 k[8]; };
struct VFr { s16x4 r[2][4][2]; };
DEV void k_issue(KFr& f, LAS const unsigned char* kt, const Geo& g) {
    const unsigned a0 = (unsigned)(size_t)(kt + g.kb0), a1 = (unsigned)(size_t)(kt + g.kb1);
    asm volatile(
        "ds_read_b128 %0, %8\n\tds_read_b128 %1, %9\n\tds_read_b128 %2, %8 offset:512\n\tds_read_b128 %3, %9 offset:512\n\t"
        "ds_read_b128 %4, %8 offset:1024\n\tds_read_b128 %5, %9 offset:1024\n\tds_read_b128 %6, %8 offset:1536\n\tds_read_b128 %7, %9 offset:1536"
        : "=&v"(f.k[0]), "=&v"(f.k[1]), "=&v"(f.k[2]), "=&v"(f.k[3]), "=&v"(f.k[4]), "=&v"(f.k[5]), "=&v"(f.k[6]), "=&v"(f.k[7])
        : "v"(a0), "v"(a1) : "memory");
}
DEV void k_wait(KFr& f) {
    asm volatile("s_waitcnt lgkmcnt(0)" : "+v"(f.k[0]), "+v"(f.k[1]), "+v"(f.k[2]), "+v"(f.k[3]), "+v"(f.k[4]), "+v"(f.k[5]), "+v"(f.k[6]), "+v"(f.k[7]));
}
DEV void v_issue(VFr& f, LAS const unsigned char* vt, const Geo& g) {
    const unsigned a0 = (unsigned)(size_t)(vt + g.vb0), a1 = (unsigned)(size_t)(vt + g.vb1);
    asm volatile(
        "ds_read_b64_tr_b16 %0, %16\n\tds_read_b64_tr_b16 %1, %17\n\t"
        "ds_read_b64_tr_b16 %2, %16 offset:512\n\tds_read_b64_tr_b16 %3, %17 offset:512\n\t"
        "ds_read_b64_tr_b16 %4, %16 offset:1024\n\tds_read_b64_tr_b16 %5, %17 offset:1024\n\t"
        "ds_read_b64_tr_b16 %6, %16 offset:1536\n\tds_read_b64_tr_b16 %7, %17 offset:1536\n\t"
        "ds_read_b64_tr_b16 %8, %16 offset:4096\n\tds_read_b64_tr_b16 %9, %17 offset:4096\n\t"
        "ds_read_b64_tr_b16 %10, %16 offset:4608\n\tds_read_b64_tr_b16 %11, %17 offset:4608\n\t"
        "ds_read_b64_tr_b16 %12, %16 offset:5120\n\tds_read_b64_tr_b16 %13, %17 offset:5120\n\t"
        "ds_read_b64_tr_b16 %14, %16 offset:5632\n\tds_read_b64_tr_b16 %15, %17 offset:5632"
        : "=&v"(f.r[0][0][0]), "=&v"(f.r[0][0][1]), "=&v"(f.r[0][1][0]), "=&v"(f.r[0][1][1]), "=&v"(f.r[0][2][0]), "=&v"(f.r[0][2][1]), "=&v"(f.r[0][3][0]), "=&v"(f.r[0][3][1]),
          "=&v"(f.r[1][0][0]), "=&v"(f.r[1][0][1]), "=&v"(f.r[1][1][0]), "=&v"(f.r[1][1][1]), "=&v"(f.r[1][2][0]), "=&v"(f.r[1][2][1]), "=&v"(f.r[1][3][0]), "=&v"(f.r[1][3][1])
        : "v"(a0), "v"(a1) : "memory");
}
DEV void v_wait(VFr& f) {
    asm volatile("s_waitcnt lgkmcnt(0)"
        : "+v"(f.r[0][0][0]), "+v"(f.r[0][0][1]), "+v"(f.r[0][1][0]), "+v"(f.r[0][1][1]), "+v"(f.r[0][2][0]), "+v"(f.r[0][2][1]), "+v"(f.r[0][3][0]), "+v"(f.r[0][3][1]),
          "+v"(f.r[1][0][0]), "+v"(f.r[1][0][1]), "+v"(f.r[1][1][0]), "+v"(f.r[1][1][1]), "+v"(f.r[1][2][0]), "+v"(f.r[1][2][1]), "+v"(f.r[1][3][0]), "+v"(f.r[1][3][1]));
}
template <int KS>
DEV f32x16 qk_raw(const KFr& kf, const f16x8 (&qf)[8], const f32x16& sc, int D0p, int hh, unsigned dmax) {
    f32x16 x = __builtin_amdgcn_mfma_f32_32x32x16_f16(kf.k[0], qf[0], sc, 0, 0, 0);
#pragma unroll
    for (int s = 1; s < 8; ++s) x = __builtin_amdgcn_mfma_f32_32x32x16_f16(kf.k[s], qf[s], x, 0, 0, 0);
    const int D0 = D0p + 4 * KS * hh;
    const bool full = __all((D0 - 31 * KS >= 0) && (D0 <= (int)dmax));
    if (!full) {
        const float NEG = -__builtin_inff();
#pragma unroll
        for (int i = 0; i < 16; ++i) { const int ci = (i & 3) + 8 * (i >> 2); const int dist = D0p - KS * ci; x[i] = ((unsigned)dist <= dmax) ? x[i] : NEG; }
    }
    return x;
}
template <int KS> DEV f32x16 make_sc(float sl) { f32x16 sc;
#pragma unroll
    for (int i = 0; i < 16; ++i) sc[i] = sl * (float)(KS * ((i & 3) + 8 * (i >> 2)));
    return sc; }
DEV void pv_mma(Att& st, const VFr& vf, const f32x16& p) {
    u32x4 pw[2];
#pragma unroll
    for (int s = 0; s < 2; ++s)
#pragma unroll
        for (int j = 0; j < 4; ++j) pw[s][j] = __builtin_bit_cast(unsigned, __builtin_amdgcn_cvt_pkrtz(p[8 * s + 2 * j], p[8 * s + 2 * j + 1]));
#pragma unroll
    for (int ks = 0; ks < 2; ++ks)
#pragma unroll
        for (int c = 0; c < 4; ++c) {
            const f16x8 vv = __builtin_shufflevector(__builtin_bit_cast(f16x4, vf.r[ks][c][0]), __builtin_bit_cast(f16x4, vf.r[ks][c][1]), 0, 1, 2, 3, 4, 5, 6, 7);
            st.acc[c] = __builtin_amdgcn_mfma_f32_32x32x16_f16(vv, __builtin_bit_cast(f16x8, pw[ks]), st.acc[c], 0, 0, 0);
        }
}
DEV void att_online(Att& st, LAS const unsigned char* vt, const Geo& g, f32x16 x, float base) {
    float tmax = fmaxf(fmaxf(x[0], x[1]), x[2]);
#pragma unroll
    for (int i = 3; i < 15; i += 2) tmax = fmaxf(fmaxf(tmax, x[i]), x[i + 1]);
    tmax = fmaxf(tmax, x[15]);
    tmax = half_max(tmax + base);
    const float mn = fmaxf(st.m, tmax);
    const float alpha = fexp2(st.m - mn);
    st.m = mn;
    const float nb = base - mn;
    float ps0 = 0.f, ps1 = 0.f;
#pragma unroll
    for (int i = 0; i < 16; i += 2) { x[i] = fexp2(x[i] + nb); x[i + 1] = fexp2(x[i + 1] + nb); ps0 += x[i]; ps1 += x[i + 1]; }
    st.l = st.l * alpha + (ps0 + ps1);
    u32x4 pw[2];
#pragma unroll
    for (int s = 0; s < 2; ++s)
#pragma unroll
        for (int j = 0; j < 4; ++j) pw[s][j] = __builtin_bit_cast(unsigned, __builtin_amdgcn_cvt_pkrtz(x[8 * s + 2 * j], x[8 * s + 2 * j + 1]));
    VFr vf; v_issue(vf, vt, g);
    if (!__all(alpha == 1.0f)) {
#pragma unroll
        for (int c = 0; c < 4; ++c)
#pragma unroll
            for (int i = 0; i < 16; ++i) st.acc[c][i] *= alpha;
    }
    v_wait(vf);
#pragma unroll
    for (int ks = 0; ks < 2; ++ks)
#pragma unroll
        for (int c = 0; c < 4; ++c) {
            const f16x8 vv = __builtin_shufflevector(__builtin_bit_cast(f16x4, vf.r[ks][c][0]), __builtin_bit_cast(f16x4, vf.r[ks][c][1]), 0, 1, 2, 3, 4, 5, 6, 7);
            st.acc[c] = __builtin_amdgcn_mfma_f32_32x32x16_f16(vv, __builtin_bit_cast(f16x8, pw[ks]), st.acc[c], 0, 0, 0);
        }
}
DEV void att_stats(float& m, float& l, const f32x16& x, float base) {
    float tmax = fmaxf(fmaxf(x[0], x[1]), x[2]);
#pragma unroll
    for (int i = 3; i < 15; i += 2) tmax = fmaxf(fmaxf(tmax, x[i]), x[i + 1]);
    tmax = fmaxf(tmax, x[15]);
    tmax = half_max(tmax + base);
    const float mn = fmaxf(m, tmax);
    const float alpha = fexp2(m - mn);
    m = mn;
    const float nb = base - mn;
    float ps0 = 0.f, ps1 = 0.f;
#pragma unroll
    for (int i = 0; i < 16; i += 2) { ps0 += fexp2(x[i] + nb); ps1 += fexp2(x[i + 1] + nb); }
    l = l * alpha + (ps0 + ps1);
}
DEV void load_q(f16x8 (&qf)[8], const f16* qrow  ) {
#pragma unroll
    for (int s = 0; s < 8; ++s) qf[s] = *(const f16x8*)(qrow + 16 * s) * (f16)QSCALE2;
}


DEV float kmax_of(const int* kmx, int slot) { const int* p = kmx + slot * 4; return sqrtf(__int_as_float(p[0]) + __int_as_float(p[1]) + __int_as_float(p[2]) + __int_as_float(p[3])); }
DEV float q_norm(const f16x8 (&qf)[8]) { float s = 0.f;
#pragma unroll
    for (int i = 0; i < 8; ++i)
#pragma unroll
        for (int j = 0; j < 8; ++j) { const float v = (float)qf[i][j]; s += v * v; }
    return sqrtf(half_sum(s)) * 1.001f; }
DEV void slot_rc(int pc, int L, int& row, int& ch) { const int a = pc >> 1, b = (L >> 2) & 7; row = 8 * a + b; const int x = (2 * a + (b >> 2)) & 3; ch = 4 * (2 * (pc & 1) + (L >> 5)) + ((L & 3) ^ x); }
DEV void dma16(const void* g, LAS unsigned char* l) { __builtin_amdgcn_global_load_lds((const unsigned*)g, (LAS unsigned*)l, 16, 0, 0); }
#define WAITV_BAR(n) do { asm volatile("s_waitcnt vmcnt(" #n ") lgkmcnt(0)" ::: "memory"); __builtin_amdgcn_s_barrier(); asm volatile("" ::: "memory"); } while (0)

DEV float gelu_tanh(float v) { const float u = 0.7978845608028654f * (v + 0.044715f * v * v * v); const float e = fexp2(-2.0f * LOG2E * u); return v / (1.0f + e); }
DEV void cmp_unit(Frame& F, int cu, int layer) {
    const int kv = cu & 1, g = (cu >> 1) & 1, ct = cu >> 2;
    const int lane = F.lane, w = F.wave, r = lane & 31, hh = lane >> 5;
    const f16* proj = (const f16*)(F.ws + WS_PROJ);
    const float* pe = (kv ? F.v_pe : F.k_pe) + (size_t)layer * 32 * 128;
    const f16* W1t = (const f16*)(F.ws + WS_W1) + (size_t)(layer * 2 + kv) * 256 * 4096;
    const f16* W2t = (const f16*)(F.ws + WS_W2) + (size_t)(layer * 2 + kv) * 128 * 256;
    LAS float* accb = (LAS float*)F.lds;
    LAS f16* hid = (LAS f16*)(F.lds + 32768);
    const int c = 32 * ct + r; const int colbase = (kv ? C_VC : C_KC) + g * 128;
    f32x16 acc[8];
#pragma unroll
    for (int n = 0; n < 8; ++n)
#pragma unroll
        for (int i = 0; i < 16; ++i) acc[n][i] = 0.f;
#pragma unroll 2
    for (int s = 0; s < 32; ++s) {
        const int l = 4 * w + (s >> 3), dd = 16 * (s & 7) + 8 * hh;
        int tok = 16 * c + l; tok = tok < S ? tok : S - 1;
        const f16x8 xv = *(const f16x8*)(proj + (size_t)tok * NINP + colbase + dd);
        const f32x4 p0 = *(const f32x4*)(pe + l * 128 + dd), p1 = *(const f32x4*)(pe + l * 128 + dd + 4);
        f16x8 af;
        af[0] = (f16)((float)xv[0] + p0.x); af[1] = (f16)((float)xv[1] + p0.y); af[2] = (f16)((float)xv[2] + p0.z); af[3] = (f16)((float)xv[3] + p0.w);
        af[4] = (f16)((float)xv[4] + p1.x); af[5] = (f16)((float)xv[5] + p1.y); af[6] = (f16)((float)xv[6] + p1.z); af[7] = (f16)((float)xv[7] + p1.w);
        const int kk = l * 128 + dd;
#pragma unroll
        for (int n = 0; n < 8; ++n) { const f16x8 bf = *(const f16x8*)(W1t + (size_t)(32 * n + r) * 4096 + kk); acc[n] = __builtin_amdgcn_mfma_f32_32x32x16_f16(af, bf, acc[n], 0, 0, 0); }
    }
    for (int ww = 0; ww < 8; ++ww) {
        if (w == ww) {
#pragma unroll
            for (int n = 0; n < 8; ++n)
#pragma unroll
                for (int i = 0; i < 16; ++i) { const int cr = (i & 3) + 8 * (i >> 2) + 4 * hh; LAS float* p = accb + cr * 256 + 32 * n + r; *p = (ww == 0) ? acc[n][i] : (*p + acc[n][i]); }
        }
        __syncthreads();
    }
    for (int e = F.tid; e < 32 * 256; e += NTHR) { const int cr = e >> 8, n = e & 255; hid[cr * 264 + n] = (f16)gelu_tanh(accb[e]); }
    __syncthreads();
    if (w < 4) {
        f32x16 o;
#pragma unroll
        for (int i = 0; i < 16; ++i) o[i] = 0.f;
#pragma unroll
        for (int s = 0; s < 16; ++s) { const f16x8 af = *(const LAS f16x8*)(hid + r * 264 + 16 * s + 8 * hh); const f16x8 bf = *(const f16x8*)(W2t + (size_t)(32 * w + r) * 256 + 16 * s + 8 * hh);
            o = __builtin_amdgcn_mfma_f32_32x32x16_f16(af, bf, o, 0, 0, 0); }
        f16* outp = (f16*)(F.ws + WS_CMP) + (size_t)((kv * 2 + g) * 1024) * 128;
#pragma unroll
        for (int i = 0; i < 16; ++i) { const int cr = (i & 3) + 8 * (i >> 2) + 4 * hh; const int cc = 32 * ct + cr; outp[(size_t)cc * 128 + 32 * w + r] = (cc < 1023) ? (f16)o[i] : (f16)0.f; }
        if (kv == 0) {
            float pm = 0.f;
#pragma unroll
            for (int i = 0; i < 16; ++i) { float sq = o[i] * o[i];
#pragma unroll
                for (int sh = 1; sh < 32; sh <<= 1) sq += __shfl_xor(sq, sh);
                pm = fmaxf(pm, sq); }
            pm = fmaxf(pm, __shfl_xor(pm, 32));
            if (lane == 0) atomicMax((int*)(F.ws + WS_CTL) + CW_KMX + layer * 96 + (20 + g) * 4 + w, __float_as_int(pm * 1.004f));
        }
    }
    asm volatile("s_waitcnt vmcnt(0)" ::: "memory");
    __syncthreads();
    if (F.tid == 0) { __builtin_amdgcn_fence(__ATOMIC_RELEASE, "agent"); asm volatile("s_waitcnt vmcnt(0)" ::: "memory"); (void)xb_add((unsigned*)(F.ws + WS_CTL) + CW_CMPD + 64 * layer, 1u); }
}

DEV const f16* a_unit_qrow(Frame& F, int u) {
    const int hp = u / 384, rem = u % 384, p = rem >> 7, nb = rem & 127;
    const int dsh = 2 * p, dil = 1 << dsh, nbr = 128 >> dsh, rr = nb / nbr, n = nb % nbr;
    const int half = F.wave >> 2, wq = (F.wave & 4) ? 3 - (F.wave & 3) : (F.wave & 3), ql = F.lane & 31, hh = F.lane >> 5;
    const int qsub = 128 * n + 32 * wq + ql, tq = qsub * dil + rr;
    return (const f16*)(F.ws + WS_PROJ) + (size_t)tq * NINP + C_QA + (2 * hp + half) * 128 + 8 * hh;
}
DEV void attn_a_unit(Frame& F, int u, f16x8 (&qf)[8], int un, int layer) {
    const int hp = u / 384, rem = u % 384, p = rem >> 7, nb = rem & 127;
    const int dsh = 2 * p, dil = 1 << dsh, nbr = 128 >> dsh;
    const int rr = nb / nbr, n = nb % nbr;
    const int lane = F.lane, half = F.wave >> 2, wq = (F.wave & 4) ? 3 - (F.wave & 3) : (F.wave & 3), ql = lane & 31, hh = lane >> 5;
    const int head = 2 * hp + half;
    const f16* proj = (const f16*)(F.ws + WS_PROJ);
    const int qsub = 128 * n + 32 * wq + ql, tq = qsub * dil + rr;
    const float sl = fexp2(-0.5f * (float)(head + 1)) * (float)dil * LOG2E;
    const unsigned dmax = (unsigned)(qsub < 128 ? qsub : 128);
    const Geo g = make_geo(lane);
    const f32x16 sc = make_sc<1>(sl);
    const float bq = q_norm(qf) * kmax_of((const int*)(F.ws + WS_CTL) + CW_KMX + layer * 96, head) + sl * 31.0f;
    Att st; att_init(st);
    LAS unsigned char* base = F.lds + half * 65536;
    int r0, c0, r1, c1; slot_rc(2 * wq, lane, r0, c0); slot_rc(2 * wq + 1, lane, r1, c1);
    const int ksub0 = 128 * (n - 1);
    const f16* colb = proj + head * 128;
#define A_ISSUE(I) do { const int Jc = (I) < 4 ? 3 - (I) : 0; LAS unsigned char* sb_ = base + ((I) & 1) * 32768 + wq * 2048; \
        _Pragma("unroll") for (int sub_ = 0; sub_ < 2; ++sub_) { \
        int s0 = ksub0 + 64 * Jc + 32 * sub_ + r0, s1 = ksub0 + 64 * Jc + 32 * sub_ + r1; s0 = s0 < 0 ? 0 : s0; s1 = s1 < 0 ? 0 : s1; \
        const f16* g0 = colb + (size_t)(s0 * dil + rr) * NINP + c0 * 8; const f16* g1 = colb + (size_t)(s1 * dil + rr) * NINP + c1 * 8; \
        dma16(g0 + C_KA, sb_ + sub_ * 16384); dma16(g1 + C_KA, sb_ + sub_ * 16384 + 1024); dma16(g0 + C_VA, sb_ + sub_ * 16384 + 8192); dma16(g1 + C_VA, sb_ + sub_ * 16384 + 8192 + 1024); } } while (0)
    A_ISSUE(0);
#pragma nounroll
    for (int i = 0; i < 4; ++i) {
        WAITV_BAR(0);
        if (i < 3) A_ISSUE(i + 1);
#pragma unroll
        for (int sub = 1; sub >= 0; --sub) {
            const int T = 2 * (3 - i) + sub;
            const int D0p = 128 + 32 * (wq - T) + ql - 4 * hh;
            if (T >= wq && T <= wq + 4 && !__all(bq - sl * (float)D0p - st.m < SKIP_LOG2)) {
                LAS unsigned char* sb = base + (i & 1) * 32768 + sub * 16384;
                KFr kf; k_issue(kf, sb, g); k_wait(kf);
                const f32x16 x = qk_raw<1>(kf, qf, sc, D0p, hh, dmax);
                att_online(st, sb + 8192, g, x, -sl * (float)D0p);
            }
        }
    }
#undef A_ISSUE
    if (un >= 0) load_q(qf, a_unit_qrow(F, un));
    const float lt = half_sum(st.l);
    const float inv = 1.0f / lt;
    LAS unsigned char* ost = base + wq * 8192;
#pragma unroll
    for (int c = 0; c < 4; ++c)
#pragma unroll
        for (int gq = 0; gq < 4; ++gq) { u32x2 w; w.x = pk2h(st.acc[c][4 * gq] * inv, st.acc[c][4 * gq + 1] * inv); w.y = pk2h(st.acc[c][4 * gq + 2] * inv, st.acc[c][4 * gq + 3] * inv);
            *(LAS u32x2*)(ost + ql * 256 + (((4 * c + gq) ^ (ql & 15)) << 4) + 8 * hh) = w; }
    asm volatile("s_waitcnt lgkmcnt(0)" ::: "memory");
    {
        const int ch = lane & 15;
        f16* oab = (f16*)(F.ws + WS_OA) + (size_t)p * S * DA + head * 128 + ch * 8;
#pragma unroll
        for (int j = 0; j < 8; ++j) { const int row = 4 * j + (lane >> 4);
            const u32x4 v = *(LAS const u32x4*)(ost + row * 256 + ((ch ^ (row & 15)) << 4));
            *(u32x4*)(oab + (size_t)((128 * n + 32 * wq + row) * dil + rr) * DA) = v; }
    }
    if (hh == 0) ((float*)(F.ws + WS_LSE))[((size_t)p * S + tq) * 16 + head] = st.m + __builtin_amdgcn_logf(lt);
    asm volatile("s_waitcnt lgkmcnt(0)" ::: "memory"); __builtin_amdgcn_s_barrier(); asm volatile("" ::: "memory");
}

constexpr int NSA_NS = 5;
DEV void nsa_unit(Frame& F, int chunk, int gq, int layer) {
    const int lane = F.lane, w = F.wave, ql = lane & 31, hh = lane >> 5, tid = F.tid;
    const int hw = w < 4 ? w : 11 - w;
    const int t0 = 32 * chunk, t = t0 + ql, head = 8 * gq + hw, cur = t0 >> 6;
    const f16* proj = (const f16*)(F.ws + WS_PROJ);
    f16x8 qf[8]; load_q(qf, proj + (size_t)t * NINP + C_QB + head * 128 + 8 * hh);
    const float sl = fexp2(-0.5f * (float)(head + 1)) * LOG2E;
    const Geo g = make_geo(lane);
    LAS unsigned char* tiles = F.lds;
    LAS float* imp = (LAS float*)(F.lds + 81920);
    LAS float* part = (LAS float*)(F.lds + 114688);
    LAS float* carry = (LAS float*)(F.lds + 147456);
    LAS unsigned* sel = (LAS unsigned*)(F.lds + 147456 + 256);
    LAS unsigned* uni = sel + 256;
    LAS unsigned* blist = sel + 272;
    int lr, lch; slot_rc(w, lane, lr, lch);
    LAS unsigned char* mypiece = tiles + w * 1024;
    f16* obr = (f16*)(F.ws + WS_OB) + (size_t)t0 * DB + head * 128 + (lane & 7) * 8;
#define NSA_STORE(br, scale, STG) do { f16* _o = obr + (size_t)(br) * S * DB; const float _s = (scale); LAS unsigned char* _g = (STG); \
        _Pragma("unroll") for (int hp_ = 0; hp_ < 2; ++hp_) { \
            _Pragma("unroll") for (int cc = 0; cc < 2; ++cc) _Pragma("unroll") for (int gg = 0; gg < 4; ++gg) { const int c = 2 * hp_ + cc; u32x2 wv; \
                wv.x = pk2h(st.acc[c][4 * gg] * _s, st.acc[c][4 * gg + 1] * _s); wv.y = pk2h(st.acc[c][4 * gg + 2] * _s, st.acc[c][4 * gg + 3] * _s); \
                *(LAS u32x2*)(_g + ql * 128 + (((4 * cc + gg) ^ (ql & 7)) << 4) + 8 * hh) = wv; } \
            asm volatile("s_waitcnt lgkmcnt(0)" ::: "memory"); \
            _Pragma("unroll") for (int j_ = 0; j_ < 4; ++j_) { const int row_ = 8 * j_ + (lane >> 3); \
                const u32x4 v_ = *(LAS const u32x4*)(_g + row_ * 128 + (((lane & 7) ^ (row_ & 7)) << 4)); \
                *(u32x4*)(_o + (size_t)row_ * DB + 64 * hp_) = v_; } \
            asm volatile("s_waitcnt lgkmcnt(0)" ::: "memory"); } } while (0)

    const f16* kwb = proj + C_KW + gq * 128 + (size_t)lr * NINP + lch * 8; const f16* vwb = proj + C_VW + gq * 128 + (size_t)lr * NINP + lch * 8;
    const int Tl = (t0 >> 5); const int Tf = Tl >= 16 ? Tl - 16 : 0; const int nw = Tl - Tf + 1;
#define W_ISSUE(I) do { LAS unsigned char* sb_ = mypiece + ((I) & 1) * 32768; \
        _Pragma("unroll") for (int sub_ = 0; sub_ < 2; ++sub_) { int tt_ = Tl - 2 * (I) - (1 - sub_); tt_ = tt_ < Tf ? Tf : tt_; const size_t ro = (size_t)(32 * tt_) * NINP; \
            dma16(kwb + ro, sb_ + sub_ * 16384); dma16(vwb + ro, sb_ + sub_ * 16384 + 8192); } } while (0)
    const f16* kc = (const f16*)(F.ws + WS_CMP) + (size_t)((0 * 2 + gq) * 1024) * 128 + (size_t)lr * 128 + lch * 8;
    const f16* vc = (const f16*)(F.ws + WS_CMP) + (size_t)((1 * 2 + gq) * 1024) * 128 + (size_t)lr * 128 + lch * 8;
    const int ntc = (t0 >> 9) + 1;
    const f32x16 sc16 = make_sc<16>(sl);
    const float qn = q_norm(qf); const int* kmx = (const int*)(F.ws + WS_CTL) + CW_KMX + layer * 96;
    const float bqC = qn * kmax_of(kmx, 20 + gq) + sl * 16.0f * 31.0f;
    float m_c = -1e30f, l_c = 0.f;
#define C1_ISSUE(I) do { const int Tc = (I) < ntc ? ntc - 1 - (I) : 0; dma16(kc + (size_t)Tc * 4096, mypiece + ((I) % NSA_NS) * 16384); } while (0)
    C1_ISSUE(0); C1_ISSUE(1); C1_ISSUE(2); C1_ISSUE(3);
#pragma nounroll
    for (int I = 0; I < ntc; ++I) {
        WAITV_BAR(3);
        const int T = ntc - 1 - I;
        const int D0p = t - 31 - 512 * T - 64 * hh;
        const bool skip = __all(bqC - sl * (float)D0p - m_c < SKIP_LOG2);
        C1_ISSUE(I + 4);
        if (!skip) {
            KFr kf; k_issue(kf, tiles + (I % NSA_NS) * 16384, g); k_wait(kf);
            const f32x16 x = qk_raw<16>(kf, qf, sc16, D0p, hh, 1u << 30);
            att_stats(m_c, l_c, x, -sl * (float)D0p);
        }
    }
#undef C1_ISSUE
    l_c = half_sum(l_c);
    const float invl_c = l_c > 0.f ? 1.0f / l_c : 0.f;
    WAITV_BAR(0);
    {
        Att st; att_init(st);
#define C2_ISSUE(T) do { const int Tc = (T) < ntc ? (T) : ntc - 1; LAS unsigned char* sb_ = mypiece + ((T) % NSA_NS) * 16384; dma16(kc + (size_t)Tc * 4096, sb_); dma16(vc + (size_t)Tc * 4096, sb_ + 8192); } while (0)
#define C2_REDUCE(tau) do { const LAS float* pp = part + ((tau) & 1) * 4096; const int q = tid >> 4, k = (tid >> 1) & 7, wh = tid & 1; float sred = 0.f; \
        _Pragma("unroll") for (int ww = 0; ww < 8; ++ww) sred += pp[((ww * 32 + q) * 8 + k) * 2 + wh]; \
        const float up = __shfl_up(sred, 1); \
        if (wh == 0) { const float add = k >= 1 ? up : ((tau) >= 1 ? carry[(((tau) - 1) & 1) * 32 + q] : 0.f); imp[q * 256 + 8 * (tau) + k] = sred + add; } \
        else if (k == 7) carry[((tau) & 1) * 32 + q] = sred; } while (0)
        C2_ISSUE(0); C2_ISSUE(1); C2_ISSUE(2); C2_ISSUE(3);
        int T0w = 0;
        while (T0w < ntc && __all(bqC - sl * (float)(t - 31 - 512 * T0w - 64 * hh) - m_c < SKIP_LOG2)) ++T0w;
#pragma nounroll
        for (int T = 0; T < T0w; ++T) {
            WAITV_BAR(6);
            C2_ISSUE(T + 4);
            if (T > 0) C2_REDUCE(T - 1);
            LAS float* pw = part + (T & 1) * 4096 + (w * 32 + ql) * 16;
#pragma unroll
            for (int gg = 0; gg < 4; ++gg) *(LAS f32x2*)(pw + (2 * gg + hh) * 2) = (f32x2){0.f, 0.f};
        }
#pragma nounroll
        for (int T = T0w; T < ntc; ++T) {
            WAITV_BAR(6);
            LAS unsigned char* sb = tiles + (T % NSA_NS) * 16384;
            KFr kf; k_issue(kf, sb, g);
            C2_ISSUE(T + 4);
            if (T > 0) C2_REDUCE(T - 1);
            k_wait(kf);
            const int D0p = t - 31 - 512 * T - 64 * hh;
            f32x16 x = qk_raw<16>(kf, qf, sc16, D0p, hh, 1u << 30);
            VFr vf; v_issue(vf, sb + 8192, g);
            const float nb = -sl * (float)D0p - m_c;
#pragma unroll
            for (int i = 0; i < 16; ++i) x[i] = fexp2(x[i] + nb) * invl_c;
            LAS float* pw = part + (T & 1) * 4096 + (w * 32 + ql) * 16;
#pragma unroll
            for (int gg = 0; gg < 4; ++gg) { f32x2 v; v.x = (x[4 * gg] + x[4 * gg + 1]) + (x[4 * gg + 2] + x[4 * gg + 3]); v.y = x[4 * gg + 3]; *(LAS f32x2*)(pw + (2 * gg + hh) * 2) = v; }
            v_wait(vf);
            pv_mma(st, vf, x);
        }
        WAITV_BAR(0);
        C2_REDUCE(ntc - 1);
#undef C2_ISSUE
#undef C2_REDUCE
        W_ISSUE(0);
        NSA_STORE(0, 1.0f, F.lds + 32768 + w * 4096);
        WAITV_BAR(63);
    }
    for (int qi = 0; qi < 4; ++qi) {
        const int qq = 4 * w + qi;
        unsigned selm = 0u;
        if (cur <= 15) {
#pragma unroll
            for (int m = 0; m < 4; ++m) if (lane + 64 * m <= cur) selm |= 1u << m;
        } else {
            int sv[4];
#pragma unroll
            for (int m = 0; m < 4; ++m) { const int j = lane + 64 * m; sv[m] = (j >= 1 && j <= cur - 2) ? __float_as_int(imp[qq * 256 + j]) : -1; }
            int thr = 0;
#pragma nounroll
            for (int bit = 30; bit >= 0; --bit) {
                const int cand = thr | (1 << bit);
                const int cnt = __popcll(__ballot(sv[0] >= cand)) + __popcll(__ballot(sv[1] >= cand)) + __popcll(__ballot(sv[2] >= cand)) + __popcll(__ballot(sv[3] >= cand));
                thr = cnt >= 13 ? cand : thr;
            }
            int cgt = 0;
#pragma unroll
            for (int m = 0; m < 4; ++m) { const bool gt = sv[m] > thr; cgt += __popcll(__ballot(gt)); if (gt) selm |= 1u << m; }
            const int need = 13 - cgt; int before = 0;
#pragma unroll
            for (int m = 0; m < 4; ++m) { const bool eq = sv[m] == thr; const unsigned long long em = __ballot(eq);
                const int rank = before + (int)__builtin_amdgcn_mbcnt_hi((unsigned)(em >> 32), __builtin_amdgcn_mbcnt_lo((unsigned)em, 0u));
                if (eq && rank < need) selm |= 1u << m; before += __popcll(em); }
#pragma unroll
            for (int m = 0; m < 4; ++m) { const int j = lane + 64 * m; if (j == 0 || j == cur || j == cur - 1) selm |= 1u << m; }
        }
#pragma unroll
        for (int m = 0; m < 4; ++m) { const unsigned long long b = __ballot((selm >> m) & 1u); if (lane == 0) { sel[qq * 8 + 2 * m] = (unsigned)b; sel[qq * 8 + 2 * m + 1] = (unsigned)(b >> 32); } }
    }
    WAITV_BAR(63);
    if (w == 0) {
        unsigned o = 0u;
        if (lane < 8) { for (int q = 0; q < 32; ++q) o |= sel[q * 8 + lane]; }
        const int pc = __popc(o); int pre = 0;
#pragma unroll
        for (int k = 0; k < 7; ++k) { const int pk = __shfl(pc, k); if (lane > k) pre += pk; }
        if (lane < 8) { unsigned wv = o; int pos = pre; while (wv) { const int b = __builtin_ctz(wv); wv &= wv - 1; blist[pos++] = (unsigned)(32 * lane + b); } }
        if (lane == 7) uni[8] = (unsigned)(pre + pc);
    }
    WAITV_BAR(63);
    const f32x16 sc1 = make_sc<1>(sl);
    const float bqS = qn * kmax_of(kmx, 16 + gq) + sl * 31.0f, bqW = qn * kmax_of(kmx, 18 + gq) + sl * 31.0f;
    const f16* ksb = proj + C_KS + gq * 128 + (size_t)lr * NINP + lch * 8; const f16* vsb = proj + C_VS + gq * 128 + (size_t)lr * NINP + lch * 8;
    const int nblk = (int)uni[8];
#define S_ISSUE(I) do { const int b_ = (int)blist[(I) < nblk ? nblk - 1 - (I) : 0]; LAS unsigned char* sb_ = F.lds + 81920 + w * 1024 + ((I) & 1) * 32768; \
        _Pragma("unroll") for (int sub_ = 0; sub_ < 2; ++sub_) { const size_t ro = (size_t)(64 * b_ + 32 * sub_) * NINP; dma16(ksb + ro, sb_ + sub_ * 16384); dma16(vsb + ro, sb_ + sub_ * 16384 + 8192); } } while (0)
    S_ISSUE(0);
    {
        Att st; att_init(st);
#pragma nounroll
        for (int i = 0; 2 * i < nw; ++i) {
            WAITV_BAR(0);
            if (2 * (i + 1) < nw) W_ISSUE(i + 1);
#pragma unroll
            for (int sub = 1; sub >= 0; --sub) {
                const int Tt = Tl - 2 * i - (1 - sub);
                const int D0p = t - 32 * Tt - 4 * hh;
                if (Tt >= Tf && !__all(bqW - sl * (float)D0p - st.m < SKIP_LOG2)) {
                    LAS unsigned char* sb = tiles + (i & 1) * 32768 + sub * 16384;
                    KFr kf; k_issue(kf, sb, g); k_wait(kf);
                    const f32x16 x = qk_raw<1>(kf, qf, sc1, D0p, hh, 511u);
                    att_online(st, sb + 8192, g, x, -sl * (float)D0p);
                }
            }
        }
#undef W_ISSUE
        const float lt = half_sum(st.l);
        NSA_STORE(2, 1.0f / lt, F.lds + (((nw + 1) >> 1) & 1) * 32768 + w * 4096);
    }
    {
        Att st; att_init(st);
        LAS unsigned char* tilesB = F.lds + 81920;
#pragma nounroll
        for (int i = 0; i < nblk; ++i) {
            WAITV_BAR(0);
            S_ISSUE(i + 1);
            const int b = (int)blist[nblk - 1 - i];
            const bool ok = (sel[ql * 8 + (b >> 5)] >> (b & 31)) & 1u;
#pragma unroll
            for (int sub = 1; sub >= 0; --sub) {
                const int kb = 64 * b + 32 * sub;
                const int D0p = t - kb - 4 * hh; const float bs = ok ? -sl * (float)D0p : -__builtin_inff();
                if (kb <= t0 + 31 && !__all(bqS + bs - st.m < SKIP_LOG2)) {
                    LAS unsigned char* sb = tilesB + (i & 1) * 32768 + sub * 16384;
                    KFr kf; k_issue(kf, sb, g); k_wait(kf);
                    const f32x16 x = qk_raw<1>(kf, qf, sc1, D0p, hh, 1u << 30);
                    att_online(st, sb + 8192, g, x, bs);
                }
            }
        }
#undef S_ISSUE
        asm volatile("s_waitcnt vmcnt(0)" ::: "memory");
        const float lt = half_sum(st.l);
        NSA_STORE(1, 1.0f / lt, F.lds + 32768 + w * 4096);
    }
#undef NSA_STORE
    WAITV_BAR(63);
}

struct P5Item { f16x8 a0[4], a1[4], a2[4], z[4]; float s0[4], s1[4], s2[4]; };
DEV void p5_load(Frame& F, P5Item& it, int item) {
    const int t = item >> 1, sideB = item & 1, lane = F.lane;
    const f16* proj = (const f16*)(F.ws + WS_PROJ) + (size_t)t * NINP;
    const f16* src = (const f16*)(F.ws + (sideB ? WS_OB : WS_OA)) + (size_t)t * DA;
    const float* lse = (const float*)(F.ws + WS_LSE) + (size_t)t * 16;
#pragma unroll
    for (int k = 0; k < 4; ++k) {
        const int col0 = 512 * k + 8 * lane, head = col0 >> 7;
        it.a0[k] = *(const f16x8*)(src + col0); it.a1[k] = *(const f16x8*)(src + (size_t)S * DA + col0); it.a2[k] = *(const f16x8*)(src + (size_t)2 * S * DA + col0);
        it.z[k] = *(const f16x8*)(proj + (sideB ? C_ZB : C_ZA) + col0);
        if (sideB) { const f16* gp = proj + C_GT + 3 * head; it.s0[k] = (float)gp[0]; it.s1[k] = (float)gp[1]; it.s2[k] = (float)gp[2]; }
        else { it.s0[k] = lse[head]; it.s1[k] = lse[(size_t)S * 16 + head]; it.s2[k] = lse[(size_t)2 * S * 16 + head]; }
    }
}
DEV void p5_compute(Frame& F, const P5Item& it, int item, int layer) {
    const int t = item >> 1, sideB = item & 1, lane = F.lane;
    const float* gg = (sideB ? F.og_b : F.og_a) + (size_t)layer * DA;
    float o[4][8]; float ss = 0.f;
#pragma unroll
    for (int k = 0; k < 4; ++k) {
        float w0, w1, w2;
        if (sideB) { w0 = 1.0f / (1.0f + fexp2(-LOG2E * it.s0[k])); w1 = 1.0f / (1.0f + fexp2(-LOG2E * it.s1[k])); w2 = 1.0f / (1.0f + fexp2(-LOG2E * it.s2[k])); }
        else { const float mx = fmaxf(it.s0[k], fmaxf(it.s1[k], it.s2[k])); w0 = fexp2(it.s0[k] - mx); w1 = fexp2(it.s1[k] - mx); w2 = fexp2(it.s2[k] - mx); const float inv = 1.0f / (w0 + w1 + w2); w0 *= inv; w1 *= inv; w2 *= inv; }
#pragma unroll
        for (int j = 0; j < 8; ++j) { o[k][j] = w0 * (float)it.a0[k][j] + w1 * (float)it.a1[k][j] + w2 * (float)it.a2[k][j]; ss += o[k][j] * o[k][j]; }
    }
    ss = wave_sum(ss);
    const float rs = 1.0f / sqrtf(ss * (1.0f / DA) + EPS);
    f16* y = (f16*)(F.ws + WS_Y) + (size_t)t * D + (sideB ? DA : 0);
#pragma unroll
    for (int k = 0; k < 4; ++k) {
        const int col0 = 512 * k + 8 * lane;
        const f32x4 g0 = *(const f32x4*)(gg + col0), g1 = *(const f32x4*)(gg + col0 + 4);
        float r[8];
#pragma unroll
        for (int j = 0; j < 8; ++j) { const float zz = (float)it.z[k][j]; const float gv = j < 4 ? g0[j & 3] : g1[j & 3]; r[j] = o[k][j] * rs * gv * (zz / (1.0f + fexp2(-LOG2E * zz))); }
        u32x4 wv; wv.x = pk2h(r[0], r[1]); wv.y = pk2h(r[2], r[3]); wv.z = pk2h(r[4], r[5]); wv.w = pk2h(r[6], r[7]);
        *(u32x4*)(y + col0) = wv;
    }
}
DEV void p5_finalize(Frame& F, int layer) {
    const bool grp = F.G == 256;
    const int xg = F.vcu >> 5, gw = grp ? 2048 * xg + NWAVES * (F.vcu & 31) + F.wave : F.vcu * NWAVES + F.wave, NGW = F.G * NWAVES;
    const int nj = grp ? 8 : (gw < S ? (S - gw + NGW - 1) / NGW : 0);
#define P5_ROW(j) (grp ? gw + 256 * (((j) + xg) & 7) : gw + NGW * (j))
    P5Item ia, ib;
    if (nj > 0) p5_load(F, ia, 2 * P5_ROW(0));
#pragma nounroll
    for (int j = 0; j < nj; ++j) {
        const int t = P5_ROW(j);
        p5_load(F, ib, 2 * t + 1);
        p5_compute(F, ia, 2 * t, layer);
        const int tn = j + 1 < nj ? P5_ROW(j + 1) : t;
        p5_load(F, ia, 2 * tn);
        p5_compute(F, ib, 2 * t + 1, layer);
    }
#undef P5_ROW
}

struct Args { const float* in[13]; float* out; unsigned char* ws; int ph_lo, ph_hi, fused, pad; };
constexpr int N_PHASES = 2 + 6 * DEPTH;

__global__ void __launch_bounds__(NTHR, 2) mega_fwd(Args args) {
    extern __shared__ __attribute__((aligned(16))) unsigned char lds_raw[];
    Frame F;
    F.lds = (LAS unsigned char*)lds_raw;
    F.tid = threadIdx.x; F.lane = F.tid & 63; F.wave = __builtin_amdgcn_readfirstlane(F.tid >> 6);
    F.G = gridDim.x; { const int bx = blockIdx.x; F.vcu = (F.G % 8 == 0) ? (bx % 8) * (F.G / 8) + bx / 8 : bx; }
    F.x = args.in[0]; F.norm_g = args.in[1]; F.w_in = args.in[2]; F.k_pe = args.in[3]; F.k_w1 = args.in[4]; F.k_w2 = args.in[5];
    F.v_pe = args.in[6]; F.v_w1 = args.in[7]; F.v_w2 = args.in[8]; F.og_a = args.in[9]; F.og_b = args.in[10]; F.w_out = args.in[11]; F.fin_g = args.in[12];
    F.out = args.out; F.ws = args.ws;
    volatile LAS unsigned* MISC = (volatile LAS unsigned*)(F.lds + MISC_OFF);
    if (F.tid < 32) MISC[F.tid] = 0u;
    __syncthreads();
    const bool fused = args.fused != 0;
    XcdBarrier bar; bar.bar = (unsigned*)(F.ws + WS_CTL) + CW_BAR; bar.x = 0; bar.st = nullptr;
    if (fused) bar = xcd_barrier_post((unsigned*)(F.ws + WS_CTL) + CW_BAR, MISC + 8);
    const int lo = args.ph_lo, hi = args.ph_hi;
    const bool grouped = F.G == 256;
    unsigned* gcnt = (unsigned*)(F.ws + WS_CTL) + CW_GRP + 64 * (F.vcu >> 5);
#define IN(k) (lo <= (k) && (k) < hi)
#define RETID() do { int _t = threadIdx.x; asm volatile("" : "+v"(_t)); F.tid = _t; F.lane = _t & 63; F.wave = __builtin_amdgcn_readfirstlane(_t >> 6); } while (0)
#define SEAM(k) do { if (fused && IN((k) + 1)) xcd_barrier(bar); } while (0)

    if (IN(0)) { RETID(); p0_prologue(F); SEAM(0); }

    for (int l = 0; l < DEPTH; ++l) {
        const int pb = 1 + 6 * l;
        if (IN(pb + 0)) { RETID(); if (l == 0) { p1_rownorm(F, F.x, (f16*)(F.ws + WS_H), (float*)(F.ws + WS_RS)); SEAM(pb + 0); } else if (!grouped) { p1_rowscale(F, (const float*)(F.ws + WS_RSP), (float*)(F.ws + WS_RS)); SEAM(pb + 0); } }
        if (IN(pb + 1)) {
            pg8::Gemm g{(const f16*)(F.ws + WS_H), (const f16*)(F.ws + WS_WIN) + (size_t)l * NINP * D, S, NINP, D};
            pg8::StaticOrder So; So.init(S, NINP, F.G, (int)blockIdx.x);
            pg8::EpiF16 E{(f16*)(F.ws + WS_PROJ), NINP, (const float*)(F.ws + WS_RS), (int*)(F.ws + WS_CTL) + CW_KMX + l * 96};
            if (grouped && l > 0) { RETID(); rowscale_tile(F, (const float*)(F.ws + WS_RSP), (float*)(F.ws + WS_RS), 8 * (F.vcu >> 5) + (F.vcu & 7)); }
            pg8::gemm_phase<pg8::EpiF16, pg8::StaticOrder, true, true>(F.lds, g, So, E);
            RETID(); backfill_wout(F, l);
            SEAM(pb + 1);
        }
        if (IN(pb + 2)) {
            const bool hasc = F.vcu < 128 && F.G == 256;
            if (F.G == 256) {
                if (hasc) { RETID(); cmp_unit(F, F.vcu, l); }
                RETID(); f16x8 qf[8]; load_q(qf, a_unit_qrow(F, F.vcu));
                constexpr int NC = 9;
                const int nu = hasc ? NC : 24 - NC;
                for (int k = 0; k < nu; ++k) {
                    const int u = k < 12 ? F.vcu + 256 * k : F.vcu - 128 + 256 * (NC + k - 12);
                    const int k1 = k + 1; const int un = k1 < nu ? (k1 < 12 ? F.vcu + 256 * k1 : F.vcu - 128 + 256 * (NC + k1 - 12)) : -1;
                    attn_a_unit(F, u, qf, un, l);
                }
            } else {
                for (int u = F.vcu; u < 128; u += F.G) { RETID(); cmp_unit(F, u, l); }
                RETID(); f16x8 qf[8]; load_q(qf, a_unit_qrow(F, F.vcu < 3072 ? F.vcu : 0));
                for (int u = F.vcu; u < 3072; u += F.G) { const int un = u + F.G < 3072 ? u + F.G : -1; attn_a_unit(F, u, qf, un, l); }
            }
        }
        if (IN(pb + 3)) {
            if (F.tid == 0) { unsigned* cd = (unsigned*)(F.ws + WS_CTL) + CW_CMPD + 64 * l; XB_SPIN(xb_ld(cd) < 128u, bar.bar); __builtin_amdgcn_fence(__ATOMIC_ACQUIRE, "agent"); asm volatile("s_waitcnt vmcnt(0)" ::: "memory"); }
            __syncthreads();
            for (int idx = F.vcu; idx < 1024; idx += F.G) {
                const int gq = (idx ^ (idx >> 8) ^ (idx >> 9)) & 1, k = idx >> 1, kq = k & 127, ki = k >> 7;
                const int chunk = ki == 0 ? kq : (ki == 1 ? 255 - kq : (ki == 2 ? 256 + kq : 511 - kq));
                RETID(); nsa_unit(F, chunk, gq, l);
            }
            SEAM(pb + 3);
        }
        if (IN(pb + 4)) { RETID(); p5_finalize(F, l); if (grouped) { if (fused && IN(pb + 5)) group_barrier(gcnt, 32u, bar.bar); } else SEAM(pb + 4); }
        if (IN(pb + 5)) {
            pg8::Gemm g{(const f16*)(F.ws + WS_Y), (const f16*)(F.ws + WS_WOUT) + (size_t)l * D * D, S, D, D};
            pg8::StaticOrder So; So.init(S, D, F.G, (int)blockIdx.x);
            pg8::EpiRes E{(f16*)(F.ws + WS_H), D, (l + 1 < DEPTH) ? (float*)(F.ws + WS_RSP) : nullptr};
            pg8::gemm_phase<pg8::EpiRes, pg8::StaticOrder, true, true>(F.lds, g, So, E);
            if (grouped) { if (fused && IN(pb + 6)) group_barrier(gcnt, 32u, bar.bar); } else SEAM(pb + 5);
        }
    }
    if (IN(N_PHASES - 1)) { RETID(); p_final(F, (const f16*)(F.ws + WS_H), F.fin_g, F.out); }
#undef IN
#undef SEAM
}

extern "C" void kernel_launch(void* const* d_in, const int* in_sizes, int n_in, void* d_out, int out_size, void* d_ws, size_t ws_size, hipStream_t stream) {
    static int grid = 0;
    if (grid == 0) {
        if (n_in != 13 || out_size != S * D || ws_size < WS_END) { fprintf(stderr, "kernel_launch: unexpected shapes (n_in %d out %d ws %zu)\n", n_in, out_size, ws_size); grid = -1; return; }
        int dev = 0, cus = 0, per_cu = 0;
        if (hipGetDevice(&dev) != hipSuccess || hipDeviceGetAttribute(&cus, hipDeviceAttributeMultiprocessorCount, dev) != hipSuccess) { grid = -1; return; }
        if (hipFuncSetAttribute((const void*)mega_fwd, hipFuncAttributeMaxDynamicSharedMemorySize, LDS_BYTES) != hipSuccess) { fprintf(stderr, "kernel_launch: hipFuncSetAttribute failed\n"); grid = -1; return; }
        if (hipOccupancyMaxActiveBlocksPerMultiprocessor(&per_cu, (const void*)mega_fwd, NTHR, LDS_BYTES) != hipSuccess || per_cu < 1) fprintf(stderr, "kernel_launch: occupancy query reports %d\n", per_cu);
        (void)hipGetLastError();
        grid = cus;
    }
    if (grid < 0) return;
    (void)hipMemsetAsync((char*)d_ws + WS_CTL, 0, CTL_ZERO_BYTES, stream);
    Args a{};
    for (int i = 0; i < 13; ++i) a.in[i] = (const float*)d_in[i];
    a.out = (float*)d_out; a.ws = (unsigned char*)d_ws; a.pad = 0;
#if MK_FUSED
    a.ph_lo = 0; a.ph_hi = N_PHASES; a.fused = 1;
    hipLaunchKernelGGL(mega_fwd, dim3(grid), dim3(NTHR), LDS_BYTES, stream, a);
#else
    for (int ph = 0; ph < N_PHASES; ++ph) { a.ph_lo = ph; a.ph_hi = ph + 1; a.fused = 0; hipLaunchKernelGGL(mega_fwd, dim3(grid), dim3(NTHR), LDS_BYTES, stream, a); }
#endif
}
```
